# Optimizing an MI355X kernel written in HIP

```python
import functools
import jax, jax.numpy as jnp
from jax import lax
import numpy as np

D_MODEL = 1024
BATCH = 4
SEQ = 8192
DEPTH = 1
DEC_BATCH = 16
DEC_SEQ = 16
PAST_LEN = 2048

CHUNK = 64
D_MIX = D_MODEL
D_ATT = D_MIX // 2
HEAD_DIM = 64
N_HEADS = D_ATT // HEAD_DIM
D_CONV = D_MIX - D_ATT
CONV_WIDTH = 31
CONV_STATE = CONV_WIDTH - 1
D_FF = 2816
Q_BLOCK = 128
N_MOD = 9
EPS = 1e-6
D_IN = 3 * D_ATT + N_HEADS + 2 * D_CONV

kernel_name = "fox_conformer_hybrid_stream_step"


def _rms(x, g):
    xf = x.astype(jnp.float32)
    y = xf * lax.rsqrt(jnp.mean(xf * xf, axis=-1, keepdims=True) + EPS)
    return (y * g.astype(jnp.float32)).astype(x.dtype)


def _layernorm(x, g, b):
    xf = x.astype(jnp.float32)
    mu = jnp.mean(xf, axis=-1, keepdims=True)
    var = jnp.mean(jnp.square(xf - mu), axis=-1, keepdims=True)
    return ((xf - mu) * lax.rsqrt(var + EPS) * g.astype(jnp.float32) + b.astype(jnp.float32)).astype(x.dtype)


def _modulate(x, g, shift, scale):
    return _rms(x, g) * (1 + scale[:, None, :]) + shift[:, None, :]


def _adaln(c, w_ada, b_ada):
    return jnp.split(jax.nn.silu(c) @ w_ada + b_ada, N_MOD, axis=-1)


def _swiglu(h, w_up, w_down):
    a, b = jnp.split(h @ w_up, 2, axis=-1)
    return (jax.nn.silu(a) * b) @ w_down


def _project_in(h, w_in, b_f, g_q, g_k):
    B, T = h.shape[:2]
    z = h @ w_in
    q, k, v, fl, u = jnp.split(z, [D_ATT, 2 * D_ATT, 3 * D_ATT, 3 * D_ATT + N_HEADS], axis=-1)
    q = _rms(q.reshape(B, T, N_HEADS, HEAD_DIM), g_q)
    k = _rms(k.reshape(B, T, N_HEADS, HEAD_DIM), g_k)
    v = v.reshape(B, T, N_HEADS, HEAD_DIM)
    logf = jax.nn.log_sigmoid((fl + b_f).astype(jnp.float32))
    a, gt = jnp.split(u, 2, axis=-1)
    u = a * jax.nn.sigmoid(gt)
    return q, k, v, logf, u


def _fox_attend(q, F_q, k, v, F_k, q_pos, k_pos):
    s = jnp.einsum('bqhd,bkhd->bhqk', q, k, preferred_element_type=jnp.float32) * (HEAD_DIM ** -0.5)
    s = s + (jnp.swapaxes(F_q, 1, 2)[..., :, None] - jnp.swapaxes(F_k, 1, 2)[..., None, :])
    s = jnp.where(k_pos[None, :] <= q_pos[:, None], s, -jnp.inf)
    p = jax.nn.softmax(s, axis=-1)
    return jnp.einsum('bhqk,bkhd->bqhd', p.astype(v.dtype), v)


def _fox_prompt(q, k, v, logf):
    B, T = q.shape[:2]
    F = jnp.cumsum(logf, axis=1)
    nb = T // Q_BLOCK
    qb = q.reshape(B, nb, Q_BLOCK, N_HEADS, HEAD_DIM).swapaxes(0, 1)
    Fb = F.reshape(B, nb, Q_BLOCK, N_HEADS).swapaxes(0, 1)
    k_pos = jnp.arange(T)

    def block(args):
        qi, Fi, i = args
        q_pos = i * Q_BLOCK + jnp.arange(Q_BLOCK)
        return _fox_attend(qi, Fi, k, v, F, q_pos, k_pos)

    o = lax.map(block, (qb, Fb, jnp.arange(nb)))
    return o.swapaxes(0, 1).reshape(B, T, N_HEADS, HEAD_DIM)


def _fox_sample(q, k, v, logf, cache_k, cache_v, cache_logf):
    L, T = cache_k.shape[1], q.shape[1]
    kk = jnp.concatenate([cache_k.astype(k.dtype), k], axis=1)
    vv = jnp.concatenate([cache_v.astype(v.dtype), v], axis=1)
    F = jnp.cumsum(jnp.concatenate([cache_logf.astype(jnp.float32), logf], axis=1), axis=1)
    q_pos = L + jnp.arange(T)
    k_pos = jnp.arange(L + T)
    return _fox_attend(q, F[:, L:], kk, vv, F, q_pos, k_pos)


def _dwconv(u_pad, conv_w, conv_b):
    y = lax.conv_general_dilated(u_pad, conv_w[:, None, :].astype(u_pad.dtype), window_strides=(1,),
                                 padding='VALID', dimension_numbers=('NWC', 'WIO', 'NWC'),
                                 feature_group_count=D_CONV)
    return y + conv_b


def _mix_out(o, u_pad, conv_w, conv_b, conv_ln_g, conv_ln_b, w_out):
    B, T = o.shape[:2]
    y = jax.nn.silu(_layernorm(_dwconv(u_pad, conv_w, conv_b), conv_ln_g, conv_ln_b))
    return jnp.concatenate([o.reshape(B, T, D_ATT), y], axis=-1) @ w_out


def _mixer_prompt(h, w_in, b_f, g_q, g_k, conv_w, conv_b, conv_ln_g, conv_ln_b, w_out):
    q, k, v, logf, u = _project_in(h, w_in, b_f, g_q, g_k)
    o = _fox_prompt(q, k, v, logf)
    u_pad = jnp.concatenate([jnp.zeros((u.shape[0], CONV_STATE, D_CONV), u.dtype), u], axis=1)
    out = _mix_out(o, u_pad, conv_w, conv_b, conv_ln_g, conv_ln_b, w_out)
    return out, (k, v, logf, u_pad[:, -CONV_STATE:])


def _mixer_sample(h, cache_k, cache_v, cache_logf, state_conv, w_in, b_f, g_q, g_k,
                  conv_w, conv_b, conv_ln_g, conv_ln_b, w_out):
    q, k, v, logf, u = _project_in(h, w_in, b_f, g_q, g_k)
    o = _fox_sample(q, k, v, logf, cache_k, cache_v, cache_logf)
    u_pad = jnp.concatenate([state_conv.astype(u.dtype), u], axis=1)
    out = _mix_out(o, u_pad, conv_w, conv_b, conv_ln_g, conv_ln_b, w_out)
    return out, (k, v, logf, u_pad[:, -CONV_STATE:])


def _layer(x, c, mixer_fn, w_ada, b_ada, g_ffn1, w_up1, w_down1, g_mix, g_ffn2, w_up2, w_down2, g_final):
    sh1, sc1, gt1, sh2, sc2, gt2, sh3, sc3, gt3 = _adaln(c, w_ada, b_ada)
    x = x + 0.5 * gt1[:, None, :] * _swiglu(_modulate(x, g_ffn1, sh1, sc1), w_up1, w_down1)
    m, states = mixer_fn(_modulate(x, g_mix, sh2, sc2))
    x = x + gt2[:, None, :] * m
    x = x + 0.5 * gt3[:, None, :] * _swiglu(_modulate(x, g_ffn2, sh3, sc3), w_up2, w_down2)
    return _rms(x, g_final), states


def setup_inputs(seed: int = 0) -> dict:
    key = jax.random.key(seed)
    ks = jax.random.split(key, 32)
    f32 = jnp.float32
    nrm = lambda k, shape, s: jax.random.normal(k, shape, f32) * s
    gain = lambda k, shape: 1.0 + 0.02 * jax.random.normal(k, shape, f32)
    return {
        "x_prompt": nrm(ks[0], (BATCH, SEQ, D_MODEL), 1.0),
        "x_sample": nrm(ks[1], (DEC_BATCH, DEC_SEQ, D_MODEL), 1.0),
        "c_prompt": nrm(ks[2], (BATCH, D_MODEL), 1.0),
        "c_sample": nrm(ks[3], (DEC_BATCH, D_MODEL), 1.0),
        "cache_k": nrm(ks[4], (DEPTH, DEC_BATCH, PAST_LEN, N_HEADS, HEAD_DIM), 1.0),
        "cache_v": nrm(ks[5], (DEPTH, DEC_BATCH, PAST_LEN, N_HEADS, HEAD_DIM), 1.0),
        "cache_logf": jax.nn.log_sigmoid(4.0 + jax.random.normal(ks[6], (DEPTH, DEC_BATCH, PAST_LEN, N_HEADS), f32)),
        "state_conv": nrm(ks[7], (DEPTH, DEC_BATCH, CONV_STATE, D_CONV), 0.5),
        "w_ada": nrm(ks[8], (DEPTH, D_MODEL, N_MOD * D_MODEL), 0.5 * D_MODEL ** -0.5),
        "b_ada": nrm(ks[9], (DEPTH, N_MOD * D_MODEL), 0.02),
        "g_ffn1": gain(ks[10], (DEPTH, D_MODEL)),
        "w_up1": nrm(ks[11], (DEPTH, D_MODEL, 2 * D_FF), D_MODEL ** -0.5),
        "w_down1": nrm(ks[12], (DEPTH, D_FF, D_MODEL), D_FF ** -0.5),
        "g_mix": gain(ks[13], (DEPTH, D_MODEL)),
        "w_in": nrm(ks[14], (DEPTH, D_MODEL, D_IN), D_MODEL ** -0.5),
        "b_f": 2.0 + 4.0 * jax.random.uniform(ks[15], (DEPTH, N_HEADS), f32),
        "g_q": gain(ks[16], (DEPTH, HEAD_DIM)),
        "g_k": gain(ks[17], (DEPTH, HEAD_DIM)),
        "conv_w": nrm(ks[18], (DEPTH, CONV_WIDTH, D_CONV), CONV_WIDTH ** -0.5),
        "conv_b": nrm(ks[19], (DEPTH, D_CONV), 0.02),
        "conv_ln_g": gain(ks[20], (DEPTH, D_CONV)),
        "conv_ln_b": nrm(ks[21], (DEPTH, D_CONV), 0.02),
        "w_out": nrm(ks[22], (DEPTH, D_MIX, D_MODEL), D_MIX ** -0.5),
        "g_ffn2": gain(ks[23], (DEPTH, D_MODEL)),
        "w_up2": nrm(ks[24], (DEPTH, D_MODEL, 2 * D_FF), D_MODEL ** -0.5),
        "w_down2": nrm(ks[25], (DEPTH, D_FF, D_MODEL), D_FF ** -0.5),
        "g_final": gain(ks[26], (DEPTH, D_MODEL)),
    }


def reference(x_prompt, x_sample, c_prompt, c_sample, cache_k, cache_v, cache_logf, state_conv,
              w_ada, b_ada, g_ffn1, w_up1, w_down1, g_mix, w_in, b_f, g_q, g_k,
              conv_w, conv_b, conv_ln_g, conv_ln_b, w_out, g_ffn2, w_up2, w_down2, g_final):
    xp, xs = x_prompt, x_sample
    kp, vp, fp, cp, ksm, vsm, fsm, csm = [], [], [], [], [], [], [], []
    for l in range(DEPTH):
        mix_w = (w_in[l], b_f[l], g_q[l], g_k[l], conv_w[l], conv_b[l], conv_ln_g[l], conv_ln_b[l], w_out[l])
        layer_w = (w_ada[l], b_ada[l], g_ffn1[l], w_up1[l], w_down1[l], g_mix[l],
                   g_ffn2[l], w_up2[l], w_down2[l], g_final[l])
        prompt_mixer = functools.partial(_mixer_prompt, w_in=mix_w[0], b_f=mix_w[1], g_q=mix_w[2], g_k=mix_w[3],
                                         conv_w=mix_w[4], conv_b=mix_w[5], conv_ln_g=mix_w[6],
                                         conv_ln_b=mix_w[7], w_out=mix_w[8])
        sample_mixer = functools.partial(_mixer_sample, cache_k=cache_k[l], cache_v=cache_v[l],
                                         cache_logf=cache_logf[l], state_conv=state_conv[l],
                                         w_in=mix_w[0], b_f=mix_w[1], g_q=mix_w[2], g_k=mix_w[3],
                                         conv_w=mix_w[4], conv_b=mix_w[5], conv_ln_g=mix_w[6],
                                         conv_ln_b=mix_w[7], w_out=mix_w[8])
        xp, (k1, v1, f1, c1) = _layer(xp, c_prompt, prompt_mixer, *layer_w)
        xs, (k2, v2, f2, c2) = _layer(xs, c_sample, sample_mixer, *layer_w)
        kp.append(k1); vp.append(v1); fp.append(f1); cp.append(c1)
        ksm.append(k2); vsm.append(v2); fsm.append(f2); csm.append(c2)
    k_prompt, v_prompt = jnp.stack(kp, 0), jnp.stack(vp, 0)
    logf_prompt, conv_prompt = jnp.stack(fp, 0), jnp.stack(cp, 0)
    k_sample, v_sample = jnp.stack(ksm, 0), jnp.stack(vsm, 0)
    logf_sample, conv_sample = jnp.stack(fsm, 0), jnp.stack(csm, 0)
    return (xp, xs, k_prompt, v_prompt, logf_prompt, conv_prompt, k_sample, v_sample, logf_sample, conv_sample)
```

```cpp
#define MK_N_LAUNCHES 12
#include <hip/hip_runtime.h>
#include <hip/hip_bf16.h>
#include <cstdio>
#include <cstdint>
#include <cmath>
namespace pg8 {
#define PG8_LAS __attribute__((address_space(3)))
typedef unsigned short bf16_t;
typedef short bf16x8 __attribute__((ext_vector_type(8)));
typedef float f32x4 __attribute__((ext_vector_type(4)));
typedef unsigned u32x4 __attribute__((ext_vector_type(4)));
constexpr int BM = 256, BK = 64, HALF = 128, HTB = HALF * BK * 2  , STAGE_BYTES = 8 * HTB, NXCD = 8, WGM = 8;

__host__ __device__ __forceinline__ int lds_byte(int r, int c) { const int st = (r >> 4) * 2 + (c >> 5), rr = r & 15, cc = c & 31, ob = rr * 64 + cc * 2; return st * 1024 + (ob ^ (((ob >> 9) & 1) << 5)); }
__host__ __device__ __forceinline__ void stage_rc(int b, int& R, int& C) { const int st = b / 1024, sb = b % 1024, swz = sb ^ (((sb >> 9) & 1) << 5); R = (st >> 1) * 16 + swz / 64; C = (st & 1) * 32 + (swz % 64) / 2; }
__host__ __device__ __forceinline__ int perm32(int rho) { const int n = rho >> 4, i = rho & 15; return 8 * (i >> 2) + 4 * n + (i & 3); }

struct Unit { int pm, pn; };
struct Gemm { const bf16_t* A; const bf16_t* Bt; int M, N, K; };

struct StaticOrder {
    int nM, nN, nwg, G, c;
    __host__ __device__ void init(int M, int N, int G_, int c_) { nM = M / BM; nN = N / BM; nwg = nM * nN; G = G_; c = c_; }
    __host__ __device__ bool next(int i, Unit& u) const {
        const long L = (long)i * G + c; if (L >= nwg) return false;
        int wgid = (int)L; { const int q = nwg / NXCD, r = nwg % NXCD, xcd = wgid % NXCD, off = wgid / NXCD; wgid = (xcd < r ? xcd * (q + 1) : r * (q + 1) + (xcd - r) * q) + off; }
        const int nig = WGM * nN, gid = wgid / nig, fm = gid * WGM, gsz = (nM - fm) < WGM ? (nM - fm) : WGM;
        u.pm = fm + ((wgid % nig) % gsz); u.pn = (wgid % nig) / gsz; return true;
    }
    __device__ __forceinline__ void a_ready(const Unit&) const {}
    __device__ __forceinline__ void done(const Unit&) const {}
};

__device__ __forceinline__ unsigned cvt_pk_bf16(float lo, float hi) { unsigned r; asm volatile("v_cvt_pk_bf16_f32 %0, %1, %2" : "=v"(r) : "v"(lo), "v"(hi)); return r; }
typedef float f32x2 __attribute__((ext_vector_type(2)));
constexpr int EP_MODW = 9216;
__device__ __forceinline__ int ep_batch(int pm, int ai, int wr, int m) { return pm < 128 ? (pm >> 5) : (4 + 8 * ai + 4 * wr + m); }
__device__ __forceinline__ float ep_silu(float x) { return x * __builtin_amdgcn_rcpf(1.0f + __builtin_amdgcn_exp2f(-1.4426950408889634f * x)); }
__device__ __forceinline__ float ep_sigmoid(float x) { return __builtin_amdgcn_rcpf(1.0f + __builtin_amdgcn_exp2f(-1.4426950408889634f * x)); }

struct EpiSwiGLU {
    static constexpr bool PERM = true, AFTER_DRAIN = false;
    bf16_t* O;
    __device__ __forceinline__ void operator()(const f32x4 (&acc)[2][2][4][2], const Unit& u, int wr, int wc, int fr, int fq) const {
        const int row0 = u.pm * BM + wr * 64 + fr, col0 = u.pn * 128 + wc * 32 + 8 * fq;
#pragma unroll
        for (int ai = 0; ai < 2; ++ai)
#pragma unroll
            for (int m = 0; m < 4; ++m) { bf16_t* rowp = O + (size_t)(row0 + ai * HALF + m * 16) * 2816 + col0;
                float h[8];
#pragma unroll
                for (int n = 0; n < 2; ++n)
#pragma unroll
                    for (int i = 0; i < 4; ++i) h[4 * n + i] = ep_silu(acc[ai][0][m][n][i]) * acc[ai][1][m][n][i];
                u32x4 w; w.x = cvt_pk_bf16(h[0], h[1]); w.y = cvt_pk_bf16(h[2], h[3]); w.z = cvt_pk_bf16(h[4], h[5]); w.w = cvt_pk_bf16(h[6], h[7]);
                *(u32x4*)rowp = w; }
    }
};
struct EpiResid {
    static constexpr bool PERM = false, AFTER_DRAIN = false;
    const float* base_p; const float* base_s; float* out; const float* gate; float coef;
    __device__ __forceinline__ void operator()(const f32x4 (&acc)[2][2][4][2], const Unit& u, int wr, int wc, int fr, int fq) const {
        const int col0 = u.pn * BM + wc * 32 + 4 * fq;
        const float* base = (u.pm < 128 ? base_p + (size_t)u.pm * BM * 1024 : base_s) + col0;
        float* o = out + (size_t)u.pm * BM * 1024 + col0;
#pragma unroll
        for (int ai = 0; ai < 2; ++ai)
#pragma unroll
            for (int m = 0; m < 4; ++m) { const int rl = ai * HALF + wr * 64 + m * 16 + fr; const float* g = gate + (size_t)ep_batch(u.pm, ai, wr, m) * EP_MODW + col0;
#pragma unroll
                for (int bj = 0; bj < 2; ++bj)
#pragma unroll
                    for (int n = 0; n < 2; ++n) { const int c = bj * HALF + n * 16; const f32x4 gv = *(const f32x4*)(g + c); const f32x4 bs = *(const f32x4*)(base + (size_t)rl * 1024 + c);
                        *(f32x4*)(o + (size_t)rl * 1024 + c) = bs + (gv * coef) * acc[ai][bj][m][n]; } }
    }
};
struct EpiIn {
    static constexpr bool PERM = true, AFTER_DRAIN = false;
    bf16_t *A2, *KB, *VB, *UB; float* dout; const float *gq, *gk; float c2;
    size_t o_kp, o_vp, o_ks, o_vs, o_cp, o_cs;
    __device__ __forceinline__ void operator()(const f32x4 (&acc)[2][2][4][2], const Unit& u, int wr, int wc, int fr, int fq) const {
        const int pn = u.pn, rowt = u.pm * BM + wr * 64 + fr;
        if (pn < 6) {
            const int sec = pn >> 1, head = 4 * (pn & 1) + wc;
            f32x4 g[2][2];
#pragma unroll
            for (int bj = 0; bj < 2; ++bj)
#pragma unroll
                for (int n = 0; n < 2; ++n) g[bj][n] = sec < 2 ? *(const f32x4*)((sec == 0 ? gq : gk) + 32 * bj + 8 * fq + 4 * n) : (f32x4){1.f, 1.f, 1.f, 1.f};
#pragma unroll
            for (int ai = 0; ai < 2; ++ai)
#pragma unroll
                for (int m = 0; m < 4; ++m) { const int row = rowt + ai * HALF + m * 16;
                    f32x4 v[2][2];
#pragma unroll
                    for (int bj = 0; bj < 2; ++bj)
#pragma unroll
                        for (int n = 0; n < 2; ++n) v[bj][n] = acc[ai][bj][m][n];
                    if (sec < 2) { float ss = 0.f;
#pragma unroll
                        for (int bj = 0; bj < 2; ++bj)
#pragma unroll
                            for (int n = 0; n < 2; ++n) ss += (v[bj][n][0] * v[bj][n][0] + v[bj][n][1] * v[bj][n][1]) + (v[bj][n][2] * v[bj][n][2] + v[bj][n][3] * v[bj][n][3]);
                        ss += __shfl_xor(ss, 16); ss += __shfl_xor(ss, 32);
                        const float r = 1.0f / sqrtf(ss * (1.0f / 64.0f) + 1e-6f);
#pragma unroll
                        for (int bj = 0; bj < 2; ++bj)
#pragma unroll
                            for (int n = 0; n < 2; ++n) v[bj][n] = v[bj][n] * r * g[bj][n]; }
                    if (sec == 0) {
#pragma unroll
                        for (int bj = 0; bj < 2; ++bj) { const f32x4 a = v[bj][0] * c2, b = v[bj][1] * c2; u32x4 w; w.x = cvt_pk_bf16(a[0], a[1]); w.y = cvt_pk_bf16(a[2], a[3]); w.z = cvt_pk_bf16(b[0], b[1]); w.w = cvt_pk_bf16(b[2], b[3]);
                            *(u32x4*)(A2 + (size_t)row * 1024 + head * 64 + 32 * bj + 8 * fq) = w; }
                    } else {
                        bf16_t* db = (sec == 1 ? KB : VB) + (size_t)row * 512 + head * 64 + 8 * fq;
                        float* df = dout + (row < 32768 ? (sec == 1 ? o_kp : o_vp) + (size_t)row * 512 : (sec == 1 ? o_ks : o_vs) + (size_t)(row - 32768) * 512) + head * 64 + 8 * fq;
#pragma unroll
                        for (int bj = 0; bj < 2; ++bj) { const f32x4 a = v[bj][0], b = v[bj][1]; u32x4 w; w.x = cvt_pk_bf16(a[0], a[1]); w.y = cvt_pk_bf16(a[2], a[3]); w.z = cvt_pk_bf16(b[0], b[1]); w.w = cvt_pk_bf16(b[2], b[3]);
                            *(u32x4*)(db + 32 * bj) = w; *(f32x4*)(df + 32 * bj) = a; *(f32x4*)(df + 32 * bj + 4) = b; }
                    } }
        } else {
            const int c0 = 128 * (pn - 6) + wc * 32 + 8 * fq;
#pragma unroll
            for (int ai = 0; ai < 2; ++ai)
#pragma unroll
                for (int m = 0; m < 4; ++m) { const int row = rowt + ai * HALF + m * 16;
                    f32x4 uu[2];
#pragma unroll
                    for (int n = 0; n < 2; ++n)
#pragma unroll
                        for (int i = 0; i < 4; ++i) uu[n][i] = acc[ai][0][m][n][i] * ep_sigmoid(acc[ai][1][m][n][i]);
                    u32x4 w; w.x = cvt_pk_bf16(uu[0][0], uu[0][1]); w.y = cvt_pk_bf16(uu[0][2], uu[0][3]); w.z = cvt_pk_bf16(uu[1][0], uu[1][1]); w.w = cvt_pk_bf16(uu[1][2], uu[1][3]);
                    *(u32x4*)(UB + (size_t)row * 512 + c0) = w;
                    if (row < 32768) { const int t = row & 8191; if (t >= 8162) { float* d = dout + o_cp + ((size_t)(row >> 13) * 30 + (t - 8162)) * 512 + c0; *(f32x4*)d = uu[0]; *(f32x4*)(d + 4) = uu[1]; } }
                    else { const int rs = row - 32768; float* d = dout + o_cs + ((size_t)(rs >> 4) * 30 + 14 + (rs & 15)) * 512 + c0; *(f32x4*)d = uu[0]; *(f32x4*)(d + 4) = uu[1]; } }
        }
    }
};

template <class Epi, class Sched, bool ALIGN_EPI = false, bool SP2 = false>
__device__ __forceinline__ void gemm_phase(PG8_LAS unsigned char* lds, const Gemm g, const Sched& S, const Epi& E) {
    const int tid = threadIdx.x, wid = __builtin_amdgcn_readfirstlane(tid >> 6), lane = tid & 63, wr = wid >> 2, wc = wid & 3, fr = lane & 15, fq = lane >> 4;
    const int K = g.K, nt = K / BK;
    unsigned voffA[2], voffB[2];
#pragma unroll
    for (int i = 0; i < 2; ++i) { int R, C; stage_rc(tid * 16 + i * 8192, R, C); const int Rb = Epi::PERM ? ((R & ~31) + perm32(R & 31)) : R;
        voffA[i] = (unsigned)(R * K + C) * 2u; voffB[i] = (unsigned)(Rb * K + C) * 2u; }
    const size_t kstep = (size_t)(BK * 2);
    const size_t hstep = (size_t)HALF * K * 2;
    const size_t tstep = 2 * hstep;
    const unsigned ldsw = (unsigned)wid * 1024u;
    const int aoff = lds_byte(wr * 64 + fr, fq * 8), boff = lds_byte(wc * 32 + fr, fq * 8);
#define PG8_SA(b, h) (((b) * 2 + (h)) * HTB)
#define PG8_SB(b, h) ((4 + (b) * 2 + (h)) * HTB)
#define PG8_STAGE(bufoff, gbase, voff) do { _Pragma("unroll") for (int _i = 0; _i < 2; ++_i) \
        __builtin_amdgcn_global_load_lds((const unsigned*)((const char*)(gbase) + (voff)[_i]), (PG8_LAS unsigned*)(lds + (bufoff) + ldsw + _i * 8192), 16, 0, 0); } while (0)
#define PG8_LDA(dst, b, h) do { _Pragma("unroll") for (int m = 0; m < 4; ++m) _Pragma("unroll") for (int k = 0; k < 2; ++k) dst[m][k] = *(const PG8_LAS bf16x8*)(lds + PG8_SA(b, h) + aoff + m * 2048 + k * 1024); } while (0)
#define PG8_LDB(dst, b, h) do { _Pragma("unroll") for (int n = 0; n < 2; ++n) _Pragma("unroll") for (int k = 0; k < 2; ++k) dst[n][k] = *(const PG8_LAS bf16x8*)(lds + PG8_SB(b, h) + boff + n * 2048 + k * 1024); } while (0)
#define PG8_MMA(ai, bj, At, Bt) do { __builtin_amdgcn_s_setprio(1); _Pragma("unroll") for (int m = 0; m < 4; ++m) _Pragma("unroll") for (int n = 0; n < 2; ++n) _Pragma("unroll") for (int k = 0; k < 2; ++k) \
        acc[ai][bj][m][n] = __builtin_amdgcn_mfma_f32_16x16x32_bf16(Bt[n][k], At[m][k], acc[ai][bj][m][n], 0, 0, 0); __builtin_amdgcn_s_setprio(0); } while (0)
#define PG8_WAIT_V(n) asm volatile("s_waitcnt vmcnt(" #n ")" ::: "memory")
#define PG8_WAIT_L(n) asm volatile("s_waitcnt lgkmcnt(" #n ")" ::: "memory")
#define PG8_BAR __builtin_amdgcn_s_barrier()
#define PG8_SCHED __builtin_amdgcn_sched_barrier(0)
    Unit cur, nxt; int ui = 0;
    if (!S.next(0, cur)) return;
    f32x4 acc[2][2][4][2];
#pragma unroll
    for (int a = 0; a < 2; ++a)
#pragma unroll
        for (int b = 0; b < 2; ++b)
#pragma unroll
            for (int m = 0; m < 4; ++m)
#pragma unroll
                for (int n = 0; n < 2; ++n) acc[a][b][m][n] = (f32x4){0.f, 0.f, 0.f, 0.f};
    bf16x8 At[4][2], B0[2][2], B1[2][2];
    const char* cA = (const char*)g.A + (size_t)cur.pm * tstep; const char* cB = (const char*)g.Bt + (size_t)cur.pn * tstep;
    S.a_ready(cur);
    if constexpr (SP2) {
        PG8_STAGE(PG8_SB(0, 0), cB, voffB); PG8_STAGE(PG8_SB(0, 1), cB + hstep, voffB); PG8_STAGE(PG8_SA(0, 0), cA, voffA); PG8_STAGE(PG8_SA(0, 1), cA + hstep, voffA);
        if (wr == 1) PG8_BAR;
        PG8_WAIT_V(2); PG8_BAR;
        PG8_STAGE(PG8_SB(1, 0), cB + kstep, voffB); PG8_STAGE(PG8_SA(1, 0), cA + kstep, voffA); PG8_STAGE(PG8_SB(1, 1), cB + hstep + kstep, voffB);
        PG8_WAIT_V(6); PG8_BAR;
    } else {
        PG8_STAGE(PG8_SB(0, 0), cB, voffB); PG8_STAGE(PG8_SA(0, 0), cA, voffA); PG8_STAGE(PG8_SB(0, 1), cB + hstep, voffB); PG8_STAGE(PG8_SA(0, 1), cA + hstep, voffA);
        if (wr == 1) PG8_BAR;
        PG8_WAIT_V(4); PG8_BAR;
        PG8_STAGE(PG8_SB(1, 0), cB + kstep, voffB); PG8_STAGE(PG8_SA(1, 0), cA + kstep, voffA); PG8_STAGE(PG8_SB(1, 1), cB + hstep + kstep, voffB);
        PG8_WAIT_V(6); PG8_BAR;
    }
    for (;;) {
        const bool has_next = S.next(ui + 1, nxt);
        const char* nA = has_next ? (const char*)g.A + (size_t)nxt.pm * tstep : cA; const char* nB = has_next ? (const char*)g.Bt + (size_t)nxt.pn * tstep : cB;
        for (int t = 0; t < nt; t += 2) {
            const bool last = (t == nt - 2);
            const char* a1 = cA + (size_t)(t + 1) * kstep;
            const char* a2 = last ? nA : cA + (size_t)(t + 2) * kstep; const char* b2 = last ? nB : cB + (size_t)(t + 2) * kstep;
            const char* a3 = a2 + kstep; const char* b3 = b2 + kstep;
            if (last && has_next) S.a_ready(nxt);
            if constexpr (SP2) {
            PG8_LDB(B0, 0, 0); PG8_LDB(B1, 0, 1); PG8_SCHED; PG8_LDA(At, 0, 0); PG8_STAGE(PG8_SA(1, 1), a1 + hstep, voffA);
            PG8_WAIT_V(8); PG8_WAIT_L(0); PG8_BAR; PG8_MMA(0, 0, At, B0); PG8_MMA(0, 1, At, B1); PG8_BAR; PG8_SCHED;
            PG8_LDA(At, 0, 1); PG8_STAGE(PG8_SB(0, 0), b2, voffB); PG8_STAGE(PG8_SB(0, 1), b2 + hstep, voffB); PG8_STAGE(PG8_SA(0, 0), a2, voffA);
            PG8_WAIT_V(8); PG8_WAIT_L(0); PG8_BAR; PG8_MMA(1, 0, At, B0); PG8_MMA(1, 1, At, B1); PG8_BAR; PG8_SCHED;
            PG8_LDB(B0, 1, 0); PG8_LDB(B1, 1, 1); PG8_SCHED; PG8_LDA(At, 1, 0); PG8_STAGE(PG8_SA(0, 1), a2 + hstep, voffA);
            PG8_WAIT_V(8); PG8_WAIT_L(0); PG8_BAR; PG8_MMA(0, 0, At, B0); PG8_MMA(0, 1, At, B1); PG8_BAR; PG8_SCHED;
            PG8_LDA(At, 1, 1); PG8_STAGE(PG8_SB(1, 0), b3, voffB); PG8_STAGE(PG8_SB(1, 1), b3 + hstep, voffB); PG8_STAGE(PG8_SA(1, 0), a3, voffA);
            PG8_WAIT_V(8); PG8_WAIT_L(0); PG8_BAR; PG8_MMA(1, 0, At, B0); PG8_MMA(1, 1, At, B1); PG8_BAR; PG8_SCHED;
            } else {
            PG8_LDB(B0, 0, 0); PG8_SCHED; PG8_LDA(At, 0, 0); PG8_STAGE(PG8_SA(1, 1), a1 + hstep, voffA);
            PG8_WAIT_L(8); PG8_BAR; PG8_WAIT_L(0); PG8_MMA(0, 0, At, B0); PG8_BAR; PG8_SCHED;
            PG8_LDB(B1, 0, 1); PG8_STAGE(PG8_SB(0, 0), b2, voffB);
            PG8_BAR; PG8_WAIT_L(0); PG8_MMA(0, 1, At, B1); PG8_BAR;
            PG8_LDA(At, 0, 1); PG8_STAGE(PG8_SA(0, 0), a2, voffA);
            PG8_BAR; PG8_WAIT_L(0); PG8_MMA(1, 0, At, B0); PG8_BAR; PG8_SCHED;
            PG8_STAGE(PG8_SB(0, 1), b2 + hstep, voffB);
            PG8_WAIT_V(6); PG8_BAR; PG8_MMA(1, 1, At, B1); PG8_BAR;
            PG8_LDB(B0, 1, 0); PG8_SCHED; PG8_LDA(At, 1, 0); PG8_STAGE(PG8_SA(0, 1), a2 + hstep, voffA);
            PG8_WAIT_L(8); PG8_BAR; PG8_WAIT_L(0); PG8_MMA(0, 0, At, B0); PG8_BAR; PG8_SCHED;
            PG8_LDB(B1, 1, 1); PG8_STAGE(PG8_SB(1, 0), b3, voffB);
            PG8_BAR; PG8_WAIT_L(0); PG8_MMA(0, 1, At, B1); PG8_BAR;
            PG8_LDA(At, 1, 1); PG8_STAGE(PG8_SA(1, 0), a3, voffA);
            PG8_BAR; PG8_WAIT_L(0); PG8_MMA(1, 0, At, B0); PG8_BAR; PG8_SCHED;
            PG8_STAGE(PG8_SB(1, 1), b3 + hstep, voffB);
            PG8_WAIT_V(6); PG8_BAR; PG8_MMA(1, 1, At, B1); PG8_BAR;
            }
        }
        if constexpr (ALIGN_EPI) { if (wr == 0) PG8_BAR; }
        if constexpr (!Epi::AFTER_DRAIN) { E(acc, cur, wr, wc, fr, fq); S.done(cur); }
        if (!has_next) break;
#pragma unroll
        for (int a = 0; a < 2; ++a)
#pragma unroll
            for (int b = 0; b < 2; ++b)
#pragma unroll
                for (int m = 0; m < 4; ++m)
#pragma unroll
                    for (int n = 0; n < 2; ++n) acc[a][b][m][n] = (f32x4){0.f, 0.f, 0.f, 0.f};
        cur = nxt; cA = nA; cB = nB; ++ui;
        if constexpr (ALIGN_EPI) { if (wr == 1) PG8_BAR; }
    }
    PG8_WAIT_V(0);
    if constexpr (!ALIGN_EPI) { if (wr == 0) PG8_BAR; }
    PG8_BAR;
    if constexpr (Epi::AFTER_DRAIN) { E.fused(acc, cur, wr, wc, fr, fq, lds, wid, lane); S.done(cur); }
#undef PG8_SA
#undef PG8_SB
#undef PG8_STAGE
#undef PG8_LDA
#undef PG8_LDB
#undef PG8_MMA
#undef PG8_WAIT_V
#undef PG8_WAIT_L
#undef PG8_BAR
#undef PG8_SCHED
}
}
#include <hip/hip_bf16.h>
namespace attn_body {
using bf16=__hip_bfloat16;
using bf16x8=__attribute__((ext_vector_type(8)))short;
using s16x4=__attribute__((ext_vector_type(4)))short;
using f32x16=__attribute__((ext_vector_type(16)))float;
using u32x4=__attribute__((ext_vector_type(4)))unsigned;
constexpr int BATCH=4,NHEAD=8,SEQ=8192,D=64,DMQ=1024,DMK=512;
constexpr int NW=8,QBLK=32,QB=QBLK*NW,KVBLK=64,NQB=SEQ/QB;
constexpr int ATTN_UNIT_ROWS=QB;
__device__ __forceinline__ int crow(int r,int hi){return (r&3)+8*(r>>2)+4*hi;}
#define SBAR() __builtin_amdgcn_sched_barrier(0)
__device__ __forceinline__ void cmask(f32x16&p0,f32x16&p1,int jb,int qrel,int hi){
  const float NEG=-INFINITY; int lim=qrel-(64*jb+4*hi); asm volatile("":"+v"(lim));
  #pragma unroll
  for(int r=0;r<16;++r){const int c=(r&3)+8*(r>>2); if(c>lim)p0[r]=NEG; if(c+32>lim)p1[r]=NEG;}
}

constexpr int NSLOT=3, SLOTB=8192;
constexpr int LDS_K=0, LDS_V=NSLOT*SLOTB, LDS_WS=2*NSLOT*SLOTB, LDS_OST=LDS_WS+NW*64*4, LDS_BYTES=LDS_OST+NW*4096, LDS_FSB=LDS_BYTES, LDS_TOTAL=LDS_FSB+SEQ*4;
constexpr float C2=0.125f*1.4426950408889634f;
__device__ __forceinline__ void glds16(const void*gsrc,unsigned lds_dst){unsigned keep;
  asm volatile("s_mov_b32 %0, m0\n\ts_mov_b32 m0, %2\n\ts_nop 0\n\tglobal_load_lds_dwordx4 %1, off\n\ts_mov_b32 m0, %0":"=&s"(keep):"v"(gsrc),"s"(lds_dst):"memory");}
__device__ __forceinline__ float max3f(float a,float b,float c){float r;asm("v_max3_f32 %0, %1, %2, %3":"=v"(r):"v"(a),"v"(b),"v"(c));return r;}
__device__ __forceinline__ float max2f(float a,float b){float r;asm("v_max_f32_e32 %0, %1, %2":"=v"(r):"v"(a),"v"(b));return r;}
__device__ __forceinline__ float fadd_s(float a,float b){float r;asm("v_add_f32_e32 %0, %1, %2":"=v"(r):"v"(a),"v"(b));return r;}
__device__ __forceinline__ float fsub_s(float a,float b){float r;asm("v_sub_f32_e32 %0, %1, %2":"=v"(r):"v"(a),"v"(b));return r;}
typedef float f32x2_t __attribute__((ext_vector_type(2))); typedef __bf16 bf16x2_t __attribute__((ext_vector_type(2)));
__device__ __forceinline__ unsigned cvtpk_s(float lo,float hi){f32x2_t v={lo,hi};bf16x2_t b=__builtin_convertvector(v,bf16x2_t);return __builtin_bit_cast(unsigned,b);}
#define WAIT_BAR(N) asm volatile("s_waitcnt vmcnt(" #N ") lgkmcnt(0)\n\ts_barrier":::"memory")

__device__ __forceinline__ void qkt(f32x16&p0,f32x16&p1,const char*Kslot,const bf16x8*qr,int r32,int hi){
  const char*kb=Kslot+hi*1024+r32*16;
  #pragma unroll
  for(int d0=0;d0<4;++d0){
    const bf16x8 b0=*reinterpret_cast<const bf16x8*>(kb+d0*2048);
    const bf16x8 b1=*reinterpret_cast<const bf16x8*>(kb+d0*2048+512);
    p0=__builtin_amdgcn_mfma_f32_32x32x16_bf16(b0,qr[d0],p0,0,0,0);p1=__builtin_amdgcn_mfma_f32_32x32x16_bf16(b1,qr[d0],p1,0,0,0);}
}
typedef __attribute__((address_space(3))) const char* lds_cptr;
typedef short v4i16_t __attribute__((ext_vector_type(4)));
__device__ __forceinline__ void kload8(bf16x8*kf,lds_cptr kp){
  kf[0]=*(const __attribute__((address_space(3))) bf16x8*)(kp);      kf[1]=*(const __attribute__((address_space(3))) bf16x8*)(kp+512);
  kf[2]=*(const __attribute__((address_space(3))) bf16x8*)(kp+2048); kf[3]=*(const __attribute__((address_space(3))) bf16x8*)(kp+2560);
  kf[4]=*(const __attribute__((address_space(3))) bf16x8*)(kp+4096); kf[5]=*(const __attribute__((address_space(3))) bf16x8*)(kp+4608);
  kf[6]=*(const __attribute__((address_space(3))) bf16x8*)(kp+6144); kf[7]=*(const __attribute__((address_space(3))) bf16x8*)(kp+6656);
}
__device__ __forceinline__ void kload2(bf16x8*kf,lds_cptr kp,int j){ kf[2*j]=*(const __attribute__((address_space(3))) bf16x8*)(kp+j*2048); kf[2*j+1]=*(const __attribute__((address_space(3))) bf16x8*)(kp+j*2048+512); }
__device__ __forceinline__ s16x4 vtr(lds_cptr p){ return __builtin_bit_cast(s16x4,__builtin_amdgcn_ds_read_tr16_b64_v4i16((__attribute__((address_space(3))) v4i16_t*)p)); }
__device__ __forceinline__ float rowmax(const f32x16&p0,const f32x16&p1){
  float a=max3f(p0[0],p0[1],p1[0]),b=max3f(p0[2],p0[3],p1[1]);a=max3f(a,p1[2],p1[3]);
  #pragma unroll
  for(int r=4;r<16;r+=4){a=max3f(a,p0[r],p0[r+1]);b=max3f(b,p0[r+2],p0[r+3]);a=max3f(a,p1[r],p1[r+1]);b=max3f(b,p1[r+2],p1[r+3]);}
  const float m=max2f(a,b);
  auto rr=__builtin_amdgcn_permlane32_swap(__float_as_uint(m),__float_as_uint(m),false,false);
  return max2f(__uint_as_float(rr[0]),__uint_as_float(rr[1]));
}
__device__ __forceinline__ void pv(f32x16*o,int vb,bf16x8 pa0,bf16x8 pa1,bf16x8 pa2,bf16x8 pa3){
  #pragma unroll
  for(int d0=0;d0<2;++d0){s16x4 lo[4],hi[4];
    #pragma unroll
    for(int ks=0;ks<4;++ks){
      asm volatile("ds_read_b64_tr_b16 %0,%1 offset:%c2":"=&v"(lo[ks]):"v"(vb),"i"(d0*4096+ks*1024):"memory");
      asm volatile("ds_read_b64_tr_b16 %0,%1 offset:%c2":"=&v"(hi[ks]):"v"(vb),"i"(d0*4096+ks*1024+512):"memory");}
    asm volatile("s_waitcnt lgkmcnt(0)":::"memory");SBAR();
    #define PK(k) (bf16x8){lo[k][0],lo[k][1],lo[k][2],lo[k][3],hi[k][0],hi[k][1],hi[k][2],hi[k][3]}
    o[d0]=__builtin_amdgcn_mfma_f32_32x32x16_bf16(pa0,PK(0),o[d0],0,0,0);
    o[d0]=__builtin_amdgcn_mfma_f32_32x32x16_bf16(pa1,PK(1),o[d0],0,0,0);
    o[d0]=__builtin_amdgcn_mfma_f32_32x32x16_bf16(pa2,PK(2),o[d0],0,0,0);
    o[d0]=__builtin_amdgcn_mfma_f32_32x32x16_bf16(pa3,PK(3),o[d0],0,0,0);
    #undef PK
  }
}

#ifndef ATTN_STORE16
#define ATTN_STORE16(p,v) (*(u32x4*)(p)=(v))
#endif
template<int THRL> __device__ __forceinline__ void attn_unit(int b,int h,int qb,const bf16*Q,const bf16*__restrict__ K,const bf16*__restrict__ V,bf16*O,const float*__restrict__ Fp,char*shm){
  const int tid=threadIdx.x,lane=tid&63,r32=lane&31,hi=lane>>5; const int wid=__builtin_amdgcn_readfirstlane(tid>>6);
  const long rowbase=(long)b*SEQ; const int q0=qb*QB;
  const bf16*Qw=Q+(rowbase+q0+wid*QBLK)*DMQ+h*D;
  const bf16*Kh=K+rowbase*DMK+h*D,*Vh=V+rowbase*DMK+h*D;
  const unsigned lds0=(unsigned)(uintptr_t)shm;
  float*wsf=(float*)(shm+LDS_WS)+wid*64;
  const bf16*ksrc=Kh+(long)lane*DMK+wid*8;
  const bf16*vsrc=Vh+(long)(16*(wid&3)+(lane>>2))*DMK+(wid>>2)*32+(lane&3)*8;
  const unsigned kdst=lds0+LDS_K+wid*1024, vdst=lds0+LDS_V+wid*1024;
  #define DMA_K(t,slot) glds16(ksrc+(long)(t)*KVBLK*DMK,(unsigned)__builtin_amdgcn_readfirstlane(kdst+(slot)))
  #define DMA_V(t,slot) glds16(vsrc+(long)(t)*KVBLK*DMK,(unsigned)__builtin_amdgcn_readfirstlane(vdst+(slot)))
  const int vb0=(int)(lds0+LDS_V)+((lane>>4)&1)*32+(lane&3)*8+(4*hi+((lane&15)>>2))*64;
  const char*Kbase=shm+LDS_K; bf16x8 kf[8];
  const lds_cptr shm3=(lds_cptr)shm; const lds_cptr kp0=shm3+LDS_K+hi*1024+r32*16; const lds_cptr vp0=shm3+LDS_V+((lane>>4)&1)*32+(lane&3)*8+(4*hi+((lane&15)>>2))*64;
  const int NT=(q0+QB)/KVBLK;
  { const float*Fh=Fp+(long)(b*NHEAD+h)*SEQ; const float fref=Fh[q0]; __attribute__((address_space(3))) float*fw=(__attribute__((address_space(3))) float*)((lds_cptr)shm+LDS_FSB);
    for(int s=tid;s<q0+QB;s+=NW*64)fw[s]=(fref-Fh[s])*1.4426950408889634f; }
  asm volatile("s_waitcnt vmcnt(0) lgkmcnt(0)":::"memory");
  const __attribute__((address_space(3))) float*fsb=(const __attribute__((address_space(3))) float*)((lds_cptr)shm+LDS_FSB)+4*hi;
  DMA_K(0,0);DMA_V(0,0);DMA_K(1,SLOTB);
  bf16x8 qr[4];
  #pragma unroll
  for(int d0=0;d0<4;++d0)qr[d0]=*reinterpret_cast<const bf16x8*>(&Qw[(long)r32*DMQ+d0*16+hi*8]);
  float mhat=0.f,l_reg=0.f;f32x16 o[2];o[0]=f32x16{};o[1]=f32x16{};
  const int qrel=wid*QBLK+r32;
  #define CMASK(P0,P1,t) do{int jb_=(t)-(NT-4); if(jb_>=0)cmask(P0,P1,jb_,qrel,hi);}while(0)
  bool resc=false;
  typedef float f32x4b __attribute__((ext_vector_type(4)));
  #define BIASC(C0,C1,t) do{ const __attribute__((address_space(3))) float*fb_=fsb+(t)*KVBLK; \
    _Pragma("unroll") for(int g_=0;g_<4;++g_){ const f32x4b x_=*(const __attribute__((address_space(3))) f32x4b*)(fb_+8*g_); const f32x4b y_=*(const __attribute__((address_space(3))) f32x4b*)(fb_+32+8*g_); \
      _Pragma("unroll") for(int i_=0;i_<4;++i_){ C0[4*g_+i_]=x_[i_]-mhat; C1[4*g_+i_]=y_[i_]-mhat; } } }while(0)
  #define START(P0,P1) do{ const float rm=rowmax(P0,P1); resc=false; \
    { const float dl=rm; mhat=fadd_s(mhat,dl); \
      _Pragma("unroll") for(int r=0;r<16;++r){P0[r]=fsub_s(P0[r],dl);P1[r]=fsub_s(P1[r],dl);} } \
    _Pragma("unroll") for(int r=0;r<16;++r)P0[r]=__builtin_amdgcn_exp2f(P0[r]); }while(0)
  #define RESC() do{ if(resc){ asm volatile("s_waitcnt lgkmcnt(0)":::"memory"); \
      _Pragma("unroll") for(int d_=0;d_<2;++d_) _Pragma("unroll") for(int r=0;r<16;++r)o[d_][r]*=wsf[crow(r,hi)]; } }while(0)
  f32x16 pA0,pA1,pB0,pB1;
  int sl_prev=0,sl_cur=0,sl_next=SLOTB;
  #define ROT() do{sl_prev=sl_cur;sl_cur=sl_next;sl_next=(sl_next==(NSLOT-1)*SLOTB)?0:sl_next+SLOTB;}while(0)
  DMA_K(2,2*SLOTB);
  WAIT_BAR(3);
  BIASC(pA0,pA1,0); qkt(pA0,pA1,Kbase,qr,r32,hi);asm volatile("s_nop 15\n\ts_nop 7":"+v"(pA0),"+v"(pA1));CMASK(pA0,pA1,0);
  START(pA0,pA1);
  _Pragma("unroll") for(int r=0;r<16;++r)pA1[r]=__builtin_amdgcn_exp2f(pA1[r]);
  WAIT_BAR(0);
  DMA_K(3,0);DMA_V(1,SLOTB);
  ROT();
  kload8(kf,kp0+sl_cur);
  WAIT_BAR(2);
  s16x4 vlo[8],vhi[8]; u32x4 pw0,pw1,pw2,pw3;
  #define PKW(P,B) cvtpk_s(P[B],P[B+1])
  #define PAF(k) __builtin_bit_cast(bf16x8,pw##k)
  #define VFR(i) (bf16x8){vlo[i][0],vlo[i][1],vlo[i][2],vlo[i][3],vhi[i][0],vhi[i][1],vhi[i][2],vhi[i][3]}
  #define PIN(x) asm volatile("":"+v"(x))
  #define MX3(a,b,c) __builtin_fmaxf(__builtin_fmaxf((a),(b)),(c))
  #define GAPA(MF,A0,A1,A2,A3,W0,W1,PW) do{ MF; sacc+=A0; sacc+=A1; sacc+=A2; sacc+=A3; PIN(sacc); W0; W1; PIN(PW); SBAR(); }while(0)
  #define EX(v) __builtin_amdgcn_exp2f(v)
  #define GAPB(MF,X,B) do{ MF; X[B]=EX(X[B]); X[B+1]=EX(X[B+1]); X[B+2]=EX(X[B+2]); X[B+3]=EX(X[B+3]); PIN(X); SBAR(); }while(0)
  #define VRD(i) do{ vlo[i]=vtr(vp_+(((i)>>2)*4096+((i)&3)*1024)); vhi[i]=vtr(vp_+(((i)>>2)*4096+((i)&3)*1024+512)); }while(0)
  #define KRD(G,j) do{ if(G){ kload2(kf,kp0+sl_next,j); SBAR(); } }while(0)
  #define STEP(C0,C1,P0,P1,t,GK,GV,GL) do{ SBAR(); \
    BIASC(C0,C1,t); SBAR(); \
    const lds_cptr vp_=vp0+sl_prev; \
    VRD(0); SBAR(); float sacc=(P0[0]+P0[1]); \
    GAPA(C0=__builtin_amdgcn_mfma_f32_32x32x16_bf16(kf[0],qr[0],C0,0,0,0), P0[2],P0[3],P0[4],P0[5],     pw0[0]=PKW(P0,0), pw0[1]=PKW(P0,2), pw0); \
    VRD(4); SBAR(); GAPA(C1=__builtin_amdgcn_mfma_f32_32x32x16_bf16(kf[1],qr[0],C1,0,0,0), P0[6],P0[7],P0[8],P0[9],     pw0[2]=PKW(P0,4), pw0[3]=PKW(P0,6), pw0); \
    VRD(1); SBAR(); GAPA(C0=__builtin_amdgcn_mfma_f32_32x32x16_bf16(kf[2],qr[1],C0,0,0,0),   P0[10],P0[11],P0[12],P0[13], pw1[0]=PKW(P0,8), pw1[1]=PKW(P0,10), pw1); \
    VRD(5); SBAR(); GAPA(C1=__builtin_amdgcn_mfma_f32_32x32x16_bf16(kf[3],qr[1],C1,0,0,0),   P0[14],P0[15],P1[0],P1[1],   pw1[2]=PKW(P0,12),pw1[3]=PKW(P0,14), pw1); \
    VRD(2); SBAR(); GAPA(C0=__builtin_amdgcn_mfma_f32_32x32x16_bf16(kf[4],qr[2],C0,0,0,0),   P1[2],P1[3],P1[4],P1[5],     pw2[0]=PKW(P1,0), pw2[1]=PKW(P1,2), pw2); \
    VRD(6); SBAR(); GAPA(C1=__builtin_amdgcn_mfma_f32_32x32x16_bf16(kf[5],qr[2],C1,0,0,0),   P1[6],P1[7],P1[8],P1[9],     pw2[2]=PKW(P1,4), pw2[3]=PKW(P1,6), pw2); \
    VRD(3); SBAR(); GAPA(C0=__builtin_amdgcn_mfma_f32_32x32x16_bf16(kf[6],qr[3],C0,0,0,0),   P1[10],P1[11],P1[12],P1[13], pw3[0]=PKW(P1,8), pw3[1]=PKW(P1,10), pw3); \
    VRD(7); SBAR(); GAPA(C1=__builtin_amdgcn_mfma_f32_32x32x16_bf16(kf[7],qr[3],C1,0,0,0),   P1[14],P1[15],0.f,0.f,       pw3[2]=PKW(P1,12),pw3[3]=PKW(P1,14), pw3); \
    l_reg+=sacc; \
    if(GK){DMA_K((t)+3,sl_cur);} if(GV){DMA_V((t)+1,sl_next);} \
    CMASK(C0,C1,t); \
    { float a=MX3(C0[0],C0[1],C1[0]),b=MX3(C0[2],C0[3],C1[1]); a=MX3(a,C1[2],C1[3]); \
      _Pragma("unroll") for(int r=4;r<16;r+=4){a=MX3(a,C0[r],C0[r+1]);b=MX3(b,C0[r+2],C0[r+3]);a=MX3(a,C1[r],C1[r+1]);b=MX3(b,C1[r+2],C1[r+3]);} \
      float rm=__builtin_fmaxf(a,b); { auto rr=__builtin_amdgcn_permlane32_swap(__float_as_uint(rm),__float_as_uint(rm),false,false); rm=__builtin_fmaxf(__uint_as_float(rr[0]),__uint_as_float(rr[1])); } \
      resc=false; \
      if(__builtin_expect(__any(rm>(float)THRL),0)){ const float dl=__builtin_fmaxf(rm,0.f); mhat+=dl; \
        _Pragma("unroll") for(int r=0;r<16;++r){C0[r]-=dl;C1[r]-=dl;} \
        const float f=__builtin_amdgcn_exp2f(-dl); l_reg*=f; if(hi==0)wsf[r32]=f; resc=true; } } \
    SBAR(); \
    GAPB(o[0]=__builtin_amdgcn_mfma_f32_32x32x16_bf16(PAF(0),VFR(0),o[0],0,0,0), C0,0); \
    GAPB(o[1]=__builtin_amdgcn_mfma_f32_32x32x16_bf16(PAF(0),VFR(4),o[1],0,0,0), C0,4); \
    KRD(GL,0); GAPB(o[0]=__builtin_amdgcn_mfma_f32_32x32x16_bf16(PAF(1),VFR(1),o[0],0,0,0), C0,8); \
    KRD(GL,1); GAPB(o[1]=__builtin_amdgcn_mfma_f32_32x32x16_bf16(PAF(1),VFR(5),o[1],0,0,0), C0,12); \
    KRD(GL,2); GAPB(o[0]=__builtin_amdgcn_mfma_f32_32x32x16_bf16(PAF(2),VFR(2),o[0],0,0,0), C1,0); \
    KRD(GL,3); GAPB(o[1]=__builtin_amdgcn_mfma_f32_32x32x16_bf16(PAF(2),VFR(6),o[1],0,0,0), C1,4); \
    GAPB(o[0]=__builtin_amdgcn_mfma_f32_32x32x16_bf16(PAF(3),VFR(3),o[0],0,0,0), C1,8); \
    GAPB(o[1]=__builtin_amdgcn_mfma_f32_32x32x16_bf16(PAF(3),VFR(7),o[1],0,0,0), C1,12); \
    }while(0)
  int t=1;
  #undef CMASK
  #define CMASK(P0,P1,t) do{}while(0)
  for(;t+5<NT;t+=2){
    STEP(pB0,pB1,pA0,pA1,t,true,true,true);     WAIT_BAR(2); RESC(); ROT();
    STEP(pA0,pA1,pB0,pB1,t+1,true,true,true);   WAIT_BAR(2); RESC(); ROT();
  }
  #undef CMASK
  #define CMASK(P0,P1,t) do{int jb_=(t)-(NT-4); if(jb_>=0)cmask(P0,P1,jb_,qrel,hi);}while(0)
  #define ENDW(tt) do{ if((tt)+3<NT){WAIT_BAR(2);} else if((tt)+2<NT){WAIT_BAR(1);} else {WAIT_BAR(0);} }while(0)
  for(;t+1<NT;t+=2){
    STEP(pB0,pB1,pA0,pA1,t,(t+3<NT),(t+1<NT),(t+1<NT));       ENDW(t);   RESC(); ROT();
    STEP(pA0,pA1,pB0,pB1,t+1,(t+4<NT),(t+2<NT),(t+2<NT));     ENDW(t+1); RESC(); ROT();
  }
  STEP(pB0,pB1,pA0,pA1,NT-1,false,false,false); RESC();
  { float sacc=pB0[0]+pB0[1]; _Pragma("unroll") for(int r=2;r<16;++r)sacc+=pB0[r]; _Pragma("unroll") for(int r=0;r<16;++r)sacc+=pB1[r]; l_reg+=sacc;
    pw0=(u32x4){PKW(pB0,0),PKW(pB0,2),PKW(pB0,4),PKW(pB0,6)};pw1=(u32x4){PKW(pB0,8),PKW(pB0,10),PKW(pB0,12),PKW(pB0,14)};pw2=(u32x4){PKW(pB1,0),PKW(pB1,2),PKW(pB1,4),PKW(pB1,6)};pw3=(u32x4){PKW(pB1,8),PKW(pB1,10),PKW(pB1,12),PKW(pB1,14)};
    SBAR(); pv(o,vb0+sl_cur,PAF(0),PAF(1),PAF(2),PAF(3)); }
  #undef PKW
  #undef PAF
  #undef VFR
  #undef PIN
  #undef MX3
  #undef GAPA
  #undef GAPB
  #undef EX
  #undef VRD
  #undef KRD
  #undef STEP
  #undef ENDW
  {auto rr=__builtin_amdgcn_permlane32_swap(__float_as_uint(l_reg),__float_as_uint(l_reg),false,false);l_reg=__uint_as_float(rr[0])+__uint_as_float(rr[1]);}
  if(hi==0)wsf[32+r32]=l_reg;asm volatile("s_waitcnt lgkmcnt(0)":::"memory");
  float rli[16];
  #pragma unroll
  for(int r=0;r<16;++r)rli[r]=__builtin_amdgcn_rcpf(wsf[32+crow(r,hi)]);
  bf16*Ow=O+(rowbase+q0+wid*QBLK)*DMQ+h*D;
  { bf16*stg=(bf16*)(shm+LDS_OST)+wid*2048;
    #pragma unroll
    for(int r=0;r<16;++r){const int orow=crow(r,hi);
      #pragma unroll
      for(int d0=0;d0<2;++d0)stg[orow*64+d0*32+r32]=__float2bfloat16(o[d0][r]*rli[r]);}
    asm volatile("s_waitcnt lgkmcnt(0)":::"memory");
    #pragma unroll
    for(int i=0;i<4;++i){const int row=i*8+(lane>>3),ch=lane&7; const u32x4 v=*(const u32x4*)(stg+row*64+ch*8); ATTN_STORE16(Ow+(long)row*DMQ+ch*8,v);} }
  asm volatile("s_waitcnt lgkmcnt(0)\n\ts_barrier":::"memory");
  #undef DMA_K
  #undef DMA_V
  #undef CMASK
  #undef START
  #undef BIASC
  #undef RESC
  #undef ROT
}
constexpr int ATTN_LDS_BYTES=LDS_TOTAL;
struct AttnTensors { const bf16* Q; const bf16* K; const bf16* V; bf16* O; const float* Fp; };
struct AttnUnit { int bh; int qb; };
struct StaticOrder {
  int vcu;
  __device__ __forceinline__ explicit StaticOrder(int grid,int block):vcu((block%8)*(grid/8)+block/8){}
  __device__ __forceinline__ bool next(int i,AttnUnit&u)const{ if(i>=4)return false; const int s=vcu&7; u.bh=vcu>>3; u.qb=(i==0)?s:(i==1)?15-s:(i==2)?16+s:31-s; return true; }
  __device__ __forceinline__ void a_ready(const AttnUnit&)const{}
  __device__ __forceinline__ void done(const AttnUnit&)const{}
};
template<class Sched,int THRL=8> __device__ __forceinline__ void attn_phase(char*lds,const AttnTensors&T,const Sched&S){
  AttnUnit u;
  for(int i=0;S.next(i,u);++i){ S.a_ready(u); attn_unit<THRL>(u.bh/NHEAD,u.bh%NHEAD,u.qb,T.Q,T.K,T.V,T.O,T.Fp,lds); S.done(u); }
}
#undef SBAR
#undef WAIT_BAR
}
#define GAS __attribute__((address_space(1)))
#define LAS __attribute__((address_space(3)))
typedef unsigned short bf16;
typedef unsigned v4u __attribute__((ext_vector_type(4)));
typedef float f32x4 __attribute__((ext_vector_type(4)));
typedef short bf16x8 __attribute__((ext_vector_type(8)));
typedef GAS unsigned gu32;
typedef GAS unsigned long long gu64;
#define RLX_AGENT __ATOMIC_RELAXED, __HIP_MEMORY_SCOPE_AGENT
#define LDS_WAIT() asm volatile("s_waitcnt lgkmcnt(0)" ::: "memory")
#define VM_WAIT() asm volatile("s_waitcnt vmcnt(0)" ::: "memory")
__device__ __forceinline__ unsigned long long rt() { return __builtin_amdgcn_s_memrealtime(); }
__device__ __forceinline__ unsigned f2bf(float f) { unsigned u = __builtin_bit_cast(unsigned, f); return (u + 0x7fffu + ((u >> 16) & 1u)) >> 16; }
__device__ __forceinline__ unsigned pk2(float lo, float hi) { return f2bf(lo) | (f2bf(hi) << 16); }

#define XB_TMO      128
#define XB_XCNT(j)  (256  + 64 * (j))
#define XB_XSUB(j)  (1280 + 64 * (j))
#define XB_XGEN(j)  (2304 + 64 * (j))
#define XB_TOP      3328
#define XB_TOPGEN   3392
#define XCD_BAR_WORDS 3456
#define XB_SPIN_CAP (1u << 18)

__device__ __forceinline__ unsigned xb_ld(unsigned* p)              { return __hip_atomic_load(p, __ATOMIC_RELAXED, __HIP_MEMORY_SCOPE_AGENT); }
__device__ __forceinline__ unsigned xb_add(unsigned* p, unsigned v) { return __hip_atomic_fetch_add(p, v, __ATOMIC_RELAXED, __HIP_MEMORY_SCOPE_AGENT); }
__device__ __forceinline__ unsigned xb_xcc_id() { return (unsigned)__builtin_amdgcn_s_getreg((3 << 11) | 20) & 0xFu; }
#define XB_SPIN(cond, bar) do { unsigned _sp = 0; while (cond) { __builtin_amdgcn_s_sleep(1); \
    if ((++_sp & 255u) == 0u) { if (xb_ld(&(bar)[XB_TMO])) break; if (_sp > XB_SPIN_CAP) { atomicAdd(&(bar)[XB_TMO], 1u); break; } } } } while (0)

struct XcdBarrier {
    unsigned* bar; unsigned x;
    volatile LAS unsigned* st;
};

__device__ __forceinline__ XcdBarrier xcd_barrier_post(unsigned* bar, volatile LAS unsigned* st) {
    XcdBarrier b; b.bar = bar; b.x = xb_xcc_id(); b.st = st;
    if (threadIdx.x == 0) (void)xb_add(&bar[XB_XCNT(b.x)], 1u);
    return b;
}
__device__ __forceinline__ void xcd_barrier_complete(unsigned* bar, unsigned x, unsigned& nloc, unsigned& nx) {
    const unsigned G = gridDim.x * gridDim.y * gridDim.z;
    unsigned sum, cnt, mine, sp = 0u;
    for (;;) {
        sum = 0u; cnt = 0u; mine = 0u;
#pragma unroll
        for (unsigned j = 0; j < 16; ++j) { const unsigned c = xb_ld(&bar[XB_XCNT(j)]); sum += c; cnt += (c > 0u) ? 1u : 0u; mine = (j == x) ? c : mine; }
        if (sum == G) break;
        __builtin_amdgcn_s_sleep(1);
        if ((++sp & 255u) == 0u) { if (xb_ld(&bar[XB_TMO])) break; if (sp > XB_SPIN_CAP) { atomicAdd(&bar[XB_TMO], 1u); break; } }
    }
    nloc = mine > 0u ? mine : 1u; nx = cnt > 0u ? cnt : 1u;
}

__device__ __forceinline__ void xcd_barrier(const XcdBarrier& b) {
    asm volatile("s_waitcnt vmcnt(0)" ::: "memory");
    __syncthreads();
    if (threadIdx.x == 0) {
        unsigned* bar = b.bar;
        __builtin_amdgcn_s_waitcnt(0);
        unsigned nloc = b.st[0], nx = b.st[1];
        if (nloc == 0u) { xcd_barrier_complete(bar, b.x, nloc, nx); b.st[0] = nloc; b.st[1] = nx; }
        const unsigned old = xb_add(&bar[XB_XSUB(b.x)], 1u);
        const unsigned gen = old / nloc;
        if (old + 1u == (gen + 1u) * nloc) {
            __builtin_amdgcn_fence(__ATOMIC_RELEASE, "agent");
            asm volatile("s_waitcnt vmcnt(0)" ::: "memory");
            const unsigned og = xb_add(&bar[XB_TOP], 1u);
            const unsigned tg = og / nx;
            if (og + 1u == (tg + 1u) * nx) xb_add(&bar[XB_TOPGEN], 1u);
            else XB_SPIN(xb_ld(&bar[XB_TOPGEN]) == tg, bar);
            __builtin_amdgcn_fence(__ATOMIC_ACQUIRE, "agent");
            xb_add(&bar[XB_XGEN(b.x)], 1u);
            asm volatile("s_waitcnt vmcnt(0)" ::: "memory");
        } else {
            XB_SPIN(xb_ld(&bar[XB_XGEN(b.x)]) == gen, bar);
            __builtin_amdgcn_fence(__ATOMIC_ACQUIRE, "agent");
            asm volatile("s_waitcnt vmcnt(0)" ::: "memory");
        }
    }
    __syncthreads();
}
constexpr int NWAVES = 8;
#ifndef MK_N_LAUNCHES
#define MK_N_LAUNCHES 1
#endif
constexpr int N_PHASES = 12;
constexpr int N_LAUNCHES = MK_N_LAUNCHES;
static_assert(N_LAUNCHES == 1 || N_LAUNCHES == N_PHASES, "MK_N_LAUNCHES is 1 or 12");

constexpr int D = 1024, FF = 2816, NUP = 2 * FF, DATT = 512, NH = 8, HD = 64, DCONV = 512, CW = 31, CS = 30;
constexpr int TP = 8192, NBP = 4, MP = NBP * TP, NBS = 16, TS = 16, MS = NBS * TS, M = MP + MS, PAST = 2048;
constexpr int NIN = 2560, DIN = 2568, NMOD = 9, MODW = NMOD * D, NB = NBP + NBS;
constexpr float EPS = 1e-6f, LOG2E = 1.4426950408889634f;
static_assert(MODW == pg8::EP_MODW && M % 256 == 0, "shapes");
constexpr size_t O_YP = 0, O_YS = O_YP + (size_t)MP * D, O_KP = O_YS + (size_t)MS * D, O_VP = O_KP + (size_t)MP * DATT, O_LP = O_VP + (size_t)MP * DATT,
    O_CP = O_LP + (size_t)MP * NH, O_KS = O_CP + (size_t)NBP * CS * DCONV, O_VS = O_KS + (size_t)MS * DATT, O_LS = O_VS + (size_t)MS * DATT, O_CS = O_LS + (size_t)MS * NH,
    O_END = O_CS + (size_t)NBS * CS * DCONV;
static_assert(O_END == 68204544, "output size");
enum { I_XP = 0, I_XS, I_CP, I_CSM, I_CK, I_CV, I_CLF, I_SCONV, I_WADA, I_BADA, I_GFFN1, I_WUP1, I_WDN1, I_GMIX, I_WIN, I_BF, I_GQ, I_GK, I_CONVW, I_CONVB, I_LNG, I_LNB, I_WOUT, I_GFFN2, I_WUP2, I_WDN2, I_GFIN, N_IN };
static_assert(N_IN == 27, "inputs");

constexpr size_t MiB = 1u << 20;
constexpr size_t WS_CTL = 0, CTL_ZERO_BYTES = 64 * 1024;
constexpr size_t WS_MODP = 1 * MiB;
constexpr size_t WS_MOD = 4 * MiB;
constexpr size_t WS_FP = 5 * MiB;
constexpr size_t WS_WUP1 = 8 * MiB, WS_WDN1 = 19 * MiB, WS_WIN = 25 * MiB, WS_WOUT = 30 * MiB, WS_WUP2 = 32 * MiB, WS_WDN2 = 43 * MiB;
constexpr size_t WS_HN = 50 * MiB;
constexpr size_t WS_X = 116 * MiB;
constexpr size_t WS_HID = 246 * MiB;
constexpr size_t WS_A2 = 246 * MiB, WS_KB = 311 * MiB, WS_VB = 344 * MiB, WS_UB = 377 * MiB;
constexpr size_t WS_END = 424 * MiB;
static_assert(WS_MODP + 4ull * NB * MODW * 4 <= WS_MOD && WS_MOD + (size_t)NB * MODW * 4 <= WS_FP && WS_FP + (size_t)NBP * NH * TP * 4 <= WS_WUP1, "ws map 1");
static_assert(WS_WUP1 + (size_t)NUP * D * 2 <= WS_WDN1 && WS_WDN1 + (size_t)D * FF * 2 <= WS_WIN && WS_WIN + (size_t)NIN * D * 2 <= WS_WOUT && WS_WOUT + (size_t)D * D * 2 <= WS_WUP2 && WS_WUP2 + (size_t)NUP * D * 2 <= WS_WDN2 && WS_WDN2 + (size_t)D * FF * 2 <= WS_HN, "ws map 2");
static_assert(WS_HN + (size_t)M * D * 2 <= WS_X && WS_X + (size_t)M * D * 4 <= WS_HID && WS_HID + (size_t)M * FF * 2 <= WS_END, "ws map 3");
static_assert(WS_A2 + (size_t)M * D * 2 <= WS_KB && WS_KB + (size_t)M * DATT * 2 <= WS_VB && WS_VB + (size_t)M * DATT * 2 <= WS_UB && WS_UB + (size_t)M * DCONV * 2 <= WS_END, "ws map 4");
constexpr int CW_BAR = 4096;

constexpr int RING_OFF = 0, RING_BYTES = 131072;
constexpr int LDSCTL_OFF = RING_BYTES, MISC_OFF = LDSCTL_OFF + 320;
constexpr int LDS_BYTES = 147456;
static_assert(MISC_OFF + 128 <= LDS_BYTES && attn_body::ATTN_LDS_BYTES <= RING_BYTES, "LDS map");

struct Frame {
    LAS unsigned char* lds;
    volatile LAS unsigned* MISC;
    int tid, lane, wave;
    int vcu, G;
};
__device__ __forceinline__ const float* inp_ptr(int i) { asm volatile("" : "+s"(i)); return ((const float* const __attribute__((address_space(4)))*)__builtin_amdgcn_kernarg_segment_ptr())[i]; }
#define INP(i) inp_ptr(i)
#define OUTP() ((float*)inp_ptr(N_IN))
#define WSP() ((unsigned char*)inp_ptr(N_IN + 1))
__device__ __forceinline__ float wave_sum(float v) {
#pragma unroll
    for (int o = 1; o < 64; o <<= 1) v += __shfl_xor(v, o);
    return v;
}
__device__ __forceinline__ float wave_max(float v) {
#pragma unroll
    for (int o = 1; o < 64; o <<= 1) v = fmaxf(v, __shfl_xor(v, o));
    return v;
}
__device__ __forceinline__ float bf2f(bf16 b) { return __builtin_bit_cast(float, (unsigned)b << 16); }

__device__ __forceinline__ void p0_mod_task(Frame& F, int task) {
    unsigned char* const ws_ = WSP();
    const int cu = task >> 2, kq = task & 3;
    LAS float* sc = (LAS float*)(F.lds);
    LAS float* red = (LAS float*)(F.lds + 20480);
    const float* cpp = INP(I_CP); const float* csp = INP(I_CSM);
    for (int e = F.tid; e < NB * 256; e += NWAVES * 64) { const int r = e >> 8, j = e & 255; const float c = r < NBP ? cpp[r * D + 256 * kq + j] : csp[(r - NBP) * D + 256 * kq + j]; sc[e] = c / (1.0f + __expf(-c)); }
    __syncthreads();
    f32x4 acc[NB];
#pragma unroll
    for (int r = 0; r < NB; ++r) acc[r] = (f32x4){0.f, 0.f, 0.f, 0.f};
    const float* Wp = INP(I_WADA) + (size_t)(256 * kq + 32 * F.wave) * MODW + 256 * cu + 4 * F.lane;
#pragma unroll 1
    for (int i = 0; i < 32; i += 4) {
        f32x4 w[4];
#pragma unroll
        for (int ii = 0; ii < 4; ++ii) w[ii] = *(const f32x4*)(Wp + (size_t)(i + ii) * MODW);
#pragma unroll
        for (int r = 0; r < NB; ++r) { const f32x4 s = *(const LAS f32x4*)(sc + r * 256 + 32 * F.wave + i); acc[r] += s[0] * w[0] + s[1] * w[1] + s[2] * w[2] + s[3] * w[3]; }
    }
#pragma unroll
    for (int half = 0; half < 2; ++half) {
#pragma unroll
        for (int r = 0; r < 10; ++r) *(LAS f32x4*)(red + (F.wave * 10 + r) * 256 + 4 * F.lane) = acc[half * 10 + r];
        __syncthreads();
        for (int e = F.tid; e < 2560; e += NWAVES * 64) { const int r = e >> 8, c = e & 255; float s = 0.f;
#pragma unroll
            for (int w = 0; w < NWAVES; ++w) s += red[(w * 10 + r) * 256 + c];
            ((float*)(ws_ + WS_MODP))[((size_t)kq * NB + half * 10 + r) * MODW + 256 * cu + c] = s; }
        __syncthreads();
    }
}
__device__ __forceinline__ void p0_transpose_item(const float* W, int K, int Nsrc, bf16* WT, int n0, int c0, LAS float* scr, int kb, int lane) {
    const int k0 = 64 * kb;
#pragma unroll 8
    for (int i = 0; i < 32; ++i) { const int kk = 2 * i + (lane >> 5); scr[kk * 33 + (lane & 31)] = W[(size_t)(k0 + kk) * Nsrc + c0 + (lane & 31)]; }
    LDS_WAIT(); asm volatile("" ::: "memory");
    const int c = lane & 7;
#pragma unroll
    for (int j = 0; j < 4; ++j) { const int n = (lane >> 3) + 8 * j; const LAS float* s = scr + (8 * c) * 33 + n;
        v4u o; o.x = pk2(s[0 * 33], s[1 * 33]); o.y = pk2(s[2 * 33], s[3 * 33]); o.z = pk2(s[4 * 33], s[5 * 33]); o.w = pk2(s[6 * 33], s[7 * 33]);
        *(GAS v4u*)(WT + (size_t)(n0 + n) * K + k0 + 8 * c) = o; }
    LDS_WAIT(); asm volatile("" ::: "memory");
}
__device__ __forceinline__ int up_src_col(int n0) { const int pn = n0 >> 8, loc = n0 & 255; return loc < 128 ? 128 * pn + loc : FF + 128 * pn + (loc - 128); }
__device__ __forceinline__ int in_src_col(int n0) { const int pn = n0 >> 8, loc = n0 & 255;
    if (pn < 6) { const int sec = pn >> 1, bj = loc >> 7, wc = (loc & 127) >> 5, head = 4 * (pn & 1) + wc; return sec * DATT + head * HD + 32 * bj; }
    return loc < 128 ? (3 * DATT + NH) + 128 * (pn - 6) + loc : (3 * DATT + NH + DCONV) + 128 * (pn - 6) + (loc - 128); }
__device__ __forceinline__ void p0_prologue(Frame& F) {
    unsigned char* const ws_ = WSP(); float* const out_ = OUTP();
    if ((int)blockIdx.x < 144) { for (int task = blockIdx.x; task < 144; task += F.G) p0_mod_task(F, task); }
    __syncthreads();
    LAS float* scr = (LAS float*)(F.lds + RING_OFF + F.wave * 16384);
    const int gw = F.vcu * NWAVES + F.wave, NGW = F.G * NWAVES;
    constexpr int I_UP = (D / 64) * (NUP / 32), I_DN = (FF / 64) * (D / 32), I_IN = (D / 64) * (NIN / 32), I_OUT = (D / 64) * (D / 32);
    constexpr int NITEMS = 2 * I_UP + 2 * I_DN + I_IN + I_OUT;
    for (int it = gw; it < NITEMS; it += NGW) {
        int r = it;
        if (r < I_UP) { const int nb = r % (NUP / 32), kb = r / (NUP / 32); p0_transpose_item(INP(I_WUP1), D, NUP, (bf16*)(ws_ + WS_WUP1), 32 * nb, up_src_col(32 * nb), scr, kb, F.lane); continue; } r -= I_UP;
        if (r < I_UP) { const int nb = r % (NUP / 32), kb = r / (NUP / 32); p0_transpose_item(INP(I_WUP2), D, NUP, (bf16*)(ws_ + WS_WUP2), 32 * nb, up_src_col(32 * nb), scr, kb, F.lane); continue; } r -= I_UP;
        if (r < I_DN) { const int nb = r % (D / 32), kb = r / (D / 32); p0_transpose_item(INP(I_WDN1), FF, D, (bf16*)(ws_ + WS_WDN1), 32 * nb, 32 * nb, scr, kb, F.lane); continue; } r -= I_DN;
        if (r < I_DN) { const int nb = r % (D / 32), kb = r / (D / 32); p0_transpose_item(INP(I_WDN2), FF, D, (bf16*)(ws_ + WS_WDN2), 32 * nb, 32 * nb, scr, kb, F.lane); continue; } r -= I_DN;
        if (r < I_IN) { const int nb = r % (NIN / 32), kb = r / (NIN / 32); p0_transpose_item(INP(I_WIN), D, DIN, (bf16*)(ws_ + WS_WIN), 32 * nb, in_src_col(32 * nb), scr, kb, F.lane); continue; } r -= I_IN;
        { const int nb = r % (D / 32), kb = r / (D / 32); p0_transpose_item(INP(I_WOUT), D, D, (bf16*)(ws_ + WS_WOUT), 32 * nb, 32 * nb, scr, kb, F.lane); }
    }
    const float* scp = INP(I_SCONV);
    for (int e = (int)blockIdx.x * NWAVES * 64 + F.tid; e < NBS * 14 * DCONV; e += F.G * NWAVES * 64) { const int b = e / (14 * DCONV), rem = e % (14 * DCONV);
        out_[O_CS + (size_t)b * CS * DCONV + rem] = scp[(size_t)b * CS * DCONV + 16 * DCONV + rem]; }
}

template <int KIND> __device__ __forceinline__ void norm_rows(Frame& F, const float* src, bf16* dst, float* dstf, float* dlogf, int nr, int bi) {
    unsigned char* const ws_ = WSP();
    const int lane = F.lane;
    f32x4 wv[4], shv[4];
    const float* g = INP(KIND == 1 ? I_GFFN1 : KIND == 2 ? I_GMIX : KIND == 3 ? I_GFFN2 : I_GFIN); const float* bada = INP(I_BADA);
#pragma unroll
    for (int j = 0; j < 4; ++j) { const int k = 4 * lane + 256 * j; const f32x4 gv = *(const f32x4*)(g + k);
        if (KIND == 4) { wv[j] = gv; shv[j] = (f32x4){0.f, 0.f, 0.f, 0.f}; }
        else if (KIND == 1) { const float* mp = (const float*)(ws_ + WS_MODP) + (size_t)bi * MODW + k; f32x4 sh = *(const f32x4*)(bada + k), sc = *(const f32x4*)(bada + D + k);
#pragma unroll
            for (int q = 0; q < 4; ++q) { sh += *(const f32x4*)(mp + (size_t)q * NB * MODW); sc += *(const f32x4*)(mp + (size_t)q * NB * MODW + D); }
            wv[j] = gv * (sc + 1.0f); shv[j] = sh; }
        else { const float* mp = (const float*)(ws_ + WS_MOD) + (size_t)bi * MODW + (KIND == 2 ? 3 : 6) * D + k; const f32x4 sh = *(const f32x4*)mp, sc = *(const f32x4*)(mp + D); wv[j] = gv * (sc + 1.0f); shv[j] = sh; } }
    f32x4 wf[KIND == 2 ? 32 : 1];
    float bfv = 0.f;
    if (KIND == 2) { const float* winp = INP(I_WIN);
#pragma unroll
        for (int j = 0; j < 4; ++j)
#pragma unroll
            for (int i = 0; i < 4; ++i) { const float* wp = winp + (size_t)(4 * lane + 256 * j + i) * DIN + 3 * DATT; wf[2 * (4 * j + i)] = *(const f32x4*)wp; wf[2 * (4 * j + i) + 1] = *(const f32x4*)(wp + 4); }
        bfv = INP(I_BF)[lane & 7];
    }
#pragma unroll 1
    for (int r = 0; r < nr; ++r) {
        const float* xr = src + (size_t)r * D + 4 * lane;
        f32x4 v[4]; float ss = 0.f;
#pragma unroll
        for (int j = 0; j < 4; ++j) { v[j] = *(const f32x4*)(xr + 256 * j); ss += (v[j][0] * v[j][0] + v[j][1] * v[j][1]) + (v[j][2] * v[j][2] + v[j][3] * v[j][3]); }
        const float rstd = 1.0f / sqrtf(wave_sum(ss) * (1.0f / D) + EPS);
#pragma unroll
        for (int j = 0; j < 4; ++j) v[j] = v[j] * rstd * wv[j] + shv[j];
        if (KIND == 4) {
#pragma unroll
            for (int j = 0; j < 4; ++j) *(f32x4*)(dstf + (size_t)r * D + 4 * lane + 256 * j) = v[j];
        } else {
            GAS unsigned long long* o8 = (GAS unsigned long long*)(dst + (size_t)r * D) + lane;
#pragma unroll
            for (int j = 0; j < 4; ++j) o8[64 * j] = (unsigned long long)pk2(v[j][0], v[j][1]) | ((unsigned long long)pk2(v[j][2], v[j][3]) << 32);
        }
        if (KIND == 2) {
            f32x4 f0 = (f32x4){0.f, 0.f, 0.f, 0.f}, f1 = f0;
#pragma unroll
            for (int j = 0; j < 4; ++j)
#pragma unroll
                for (int i = 0; i < 4; ++i) { f0 += v[j][i] * wf[2 * (4 * j + i)]; f1 += v[j][i] * wf[2 * (4 * j + i) + 1]; }
            float fl[8] = {f0[0], f0[1], f0[2], f0[3], f1[0], f1[1], f1[2], f1[3]};
            float mine = 0.f;
#pragma unroll
            for (int h = 0; h < 8; ++h) { const float s = wave_sum(fl[h]); if ((lane & 7) == h) mine = s; }
            const float z = mine + bfv;
            const float lf = fminf(z, 0.f) - log1pf(__expf(-fabsf(z)));
            if (lane < 8) dlogf[(size_t)r * NH + lane] = lf;
        }
    }
}
template <int KIND> __device__ __forceinline__ void norm_phase(Frame& F) {
    unsigned char* const ws_ = WSP(); float* const out_ = OUTP();
    float* X = (float*)(ws_ + WS_X); bf16* HN = (bf16*)(ws_ + WS_HN);
    if (KIND == 1) {
        const float* mp = (const float*)(ws_ + WS_MODP); float* mo = (float*)(ws_ + WS_MOD); const float* bada = INP(I_BADA);
        for (int e = (int)blockIdx.x * NWAVES * 64 + F.tid; e < NB * MODW; e += F.G * NWAVES * 64)
            mo[e] = ((mp[e] + mp[e + (size_t)NB * MODW]) + (mp[e + 2 * (size_t)NB * MODW] + mp[e + 3 * (size_t)NB * MODW])) + bada[e % MODW];
    }
    const float* xpp = KIND == 1 ? INP(I_XP) : X; const float* xsp = KIND == 1 ? INP(I_XS) : X + (size_t)MP * D;
    for (int ch = F.vcu * NWAVES + F.wave; ch < MP / 16; ch += F.G * NWAVES) {
        const int r0 = 16 * ch, bi = r0 / TP;
        const float* src = xpp + (size_t)r0 * D;
        norm_rows<KIND>(F, src, HN + (size_t)r0 * D, out_ + O_YP + (size_t)r0 * D, out_ + O_LP + (size_t)r0 * NH, 16, bi);
    }
    for (int r = F.vcu * NWAVES + F.wave; r < MS; r += F.G * NWAVES) {
        const int bi = NBP + r / TS;
        const float* src = xsp + (size_t)r * D;
        norm_rows<KIND>(F, src, HN + (size_t)(MP + r) * D, out_ + O_YS + (size_t)r * D, out_ + O_LS + (size_t)r * NH, 1, bi);
    }
}

__device__ __forceinline__ void fscan_batch(Frame& F, int b) {
    unsigned char* const ws_ = WSP(); float* const out_ = OUTP();
    LAS float* wtot = (LAS float*)(F.lds);
    const float* lf = out_ + O_LP + (size_t)b * TP * NH;
    float* FP = (float*)(ws_ + WS_FP) + (size_t)b * NH * TP;
    const int t0 = 16 * F.tid;
    float tot[8];
#pragma unroll
    for (int h = 0; h < 8; ++h) tot[h] = 0.f;
#pragma unroll 4
    for (int tt = 0; tt < 16; ++tt) { const f32x4 a = *(const f32x4*)(lf + (size_t)(t0 + tt) * NH), c = *(const f32x4*)(lf + (size_t)(t0 + tt) * NH + 4);
        tot[0] += a[0]; tot[1] += a[1]; tot[2] += a[2]; tot[3] += a[3]; tot[4] += c[0]; tot[5] += c[1]; tot[6] += c[2]; tot[7] += c[3]; }
    float pre[8];
#pragma unroll
    for (int h = 0; h < 8; ++h) { float inc = tot[h];
#pragma unroll
        for (int o = 1; o < 64; o <<= 1) { const float n = __shfl_up(inc, o); if (F.lane >= o) inc += n; }
        pre[h] = inc - tot[h]; if (F.lane == 63) wtot[F.wave * 8 + h] = inc; }
    __syncthreads();
#pragma unroll
    for (int h = 0; h < 8; ++h) { float s = 0.f; for (int w = 0; w < F.wave; ++w) s += wtot[w * 8 + h]; pre[h] += s; }
#pragma unroll 4
    for (int tt = 0; tt < 16; ++tt) { const f32x4 a = *(const f32x4*)(lf + (size_t)(t0 + tt) * NH), c = *(const f32x4*)(lf + (size_t)(t0 + tt) * NH + 4);
        pre[0] += a[0]; pre[1] += a[1]; pre[2] += a[2]; pre[3] += a[3]; pre[4] += c[0]; pre[5] += c[1]; pre[6] += c[2]; pre[7] += c[3];
#pragma unroll
        for (int h = 0; h < 8; ++h) FP[(size_t)h * TP + t0 + tt] = pre[h]; }
    __syncthreads();
}

__device__ __forceinline__ void conv_unit(Frame& F, int u) {
    unsigned char* const ws_ = WSP();
    LAS float* ylds = (LAS float*)(F.lds);
    const int c = F.tid;
    const bool smp = u >= 512;
    const int b = smp ? u - 512 : u >> 7, t0 = smp ? 0 : 64 * (u & 127), nrows = smp ? TS : 64;
    const size_t rowbase = smp ? (size_t)MP + (size_t)b * TS : (size_t)b * TP;
    const bf16* UBp = (const bf16*)(ws_ + WS_UB) + rowbase * DCONV + c;
    const float* st = INP(I_SCONV) + (size_t)b * CS * DCONV + c;
    float w[CW]; const float* cwp = INP(I_CONVW);
#pragma unroll
    for (int j = 0; j < CW; ++j) w[j] = cwp[j * DCONV + c];
    const float cb = INP(I_CONVB)[c];
    float win[32];
#pragma unroll
    for (int s = 0; s < 32; ++s) { const int t = t0 - 32 + s; float v = 0.f;
        if (t >= 0) v = bf2f(UBp[(size_t)t * DCONV]); else if (smp && t >= -CS) v = st[(size_t)(CS + t) * DCONV];
        win[s] = v; }
    for (int chunk = 0; chunk * 32 < nrows; ++chunk) {
        float nw[32];
#pragma unroll
        for (int s = 0; s < 32; ++s) { const int tl = chunk * 32 + s; nw[s] = tl < nrows ? bf2f(UBp[(size_t)(t0 + tl) * DCONV]) : 0.f; }
#pragma unroll
        for (int s = 0; s < 32; ++s) { win[s] = nw[s]; float a = cb;
#pragma unroll
            for (int j = 0; j < CW; ++j) a += w[j] * win[(s - 30 + j) & 31];
            ylds[(chunk * 32 + s) * DCONV + c] = a; }
    }
    __syncthreads();
    { const int lane = F.lane; const float* lng = INP(I_LNG); const float* lnb = INP(I_LNB); f32x4 g0 = *(const f32x4*)(lng + 8 * lane), g1 = *(const f32x4*)(lng + 8 * lane + 4), b0 = *(const f32x4*)(lnb + 8 * lane), b1 = *(const f32x4*)(lnb + 8 * lane + 4);
        bf16* A2 = (bf16*)(ws_ + WS_A2);
        for (int r = F.wave; r < nrows; r += NWAVES) {
            f32x4 y0 = *(const LAS f32x4*)(ylds + r * DCONV + 8 * lane), y1 = *(const LAS f32x4*)(ylds + r * DCONV + 8 * lane + 4);
            const float mu = wave_sum((y0[0] + y0[1]) + (y0[2] + y0[3]) + (y1[0] + y1[1]) + (y1[2] + y1[3])) * (1.0f / DCONV);
            y0 = y0 - mu; y1 = y1 - mu;
            const float var = wave_sum((y0[0] * y0[0] + y0[1] * y0[1]) + (y0[2] * y0[2] + y0[3] * y0[3]) + (y1[0] * y1[0] + y1[1] * y1[1]) + (y1[2] * y1[2] + y1[3] * y1[3])) * (1.0f / DCONV);
            const float rs = 1.0f / sqrtf(var + EPS);
            y0 = y0 * rs * g0 + b0; y1 = y1 * rs * g1 + b1;
            float o[8];
#pragma unroll
            for (int i = 0; i < 4; ++i) { o[i] = pg8::ep_silu(y0[i]); o[4 + i] = pg8::ep_silu(y1[i]); }
            v4u pk; pk.x = pk2(o[0], o[1]); pk.y = pk2(o[2], o[3]); pk.z = pk2(o[4], o[5]); pk.w = pk2(o[6], o[7]);
            *(GAS v4u*)(A2 + (rowbase + t0 + r) * D + DATT + 8 * lane) = pk;
        } }
    __syncthreads();
}

__device__ __forceinline__ void sattn_unit(Frame& F, int b, int h) {
    unsigned char* const ws_ = WSP(); float* const out_ = OUTP();
    LAS float* qs = (LAS float*)(F.lds);
    LAS float* bias = qs + 1024;
    LAS float* S = bias + 2080;
    LAS float* mrow = S + 16 * 512;
    LAS float* lrow = mrow + 16; LAS float* arow = lrow + 16;
    LAS float* wtot = arow + 16;
    LAS float* ored = wtot + 16;
    const int tid = F.tid, lane = F.lane, wave = F.wave;
    const bf16* A2 = (const bf16*)(ws_ + WS_A2); const float* ckp = INP(I_CK); const float* cvp = INP(I_CV);
    for (int e = tid; e < TS * HD; e += NWAVES * 64) { const int t = e >> 6, d = e & 63; qs[e] = bf2f(A2[((size_t)MP + b * TS + t) * D + h * HD + d]); }
    if (tid < 16) { mrow[tid] = -INFINITY; lrow[tid] = 0.f; }
    { const float* clf = INP(I_CLF) + (size_t)b * PAST * NH + h; float v[4], run = 0.f;
#pragma unroll
        for (int i = 0; i < 4; ++i) { run += clf[(size_t)(4 * tid + i) * NH]; v[i] = run; }
        float inc = run;
#pragma unroll
        for (int o = 1; o < 64; o <<= 1) { const float n = __shfl_up(inc, o); if (lane >= o) inc += n; }
        if (lane == 63) wtot[wave] = inc;
        __syncthreads();
        float pre = inc - run, total = 0.f;
        for (int w = 0; w < NWAVES; ++w) { const float x = wtot[w]; if (w < wave) pre += x; total += x; }
#pragma unroll
        for (int i = 0; i < 4; ++i) bias[4 * tid + i] = (total - (pre + v[i])) * LOG2E;
        if (tid == 0) { const float* lfn = out_ + O_LS + (size_t)b * TS * NH + h; float r2 = 0.f; for (int i = 0; i < TS; ++i) { r2 += lfn[i * NH]; bias[PAST + i] = -r2 * LOG2E; } }
    }
    __syncthreads();
    float o[16];
#pragma unroll
    for (int t = 0; t < 16; ++t) o[t] = 0.f;
    for (int ch = 0; ch < 5; ++ch) {
        const int nk = ch < 4 ? 512 : TS;
        if (tid < nk) {
            const float* kp = ch < 4 ? ckp + (((size_t)b * PAST + 512 * ch + tid) * NH + h) * HD : out_ + O_KS + (((size_t)b * TS + tid) * NH + h) * HD;
            f32x4 kk[16];
#pragma unroll
            for (int d4 = 0; d4 < 16; ++d4) kk[d4] = *(const f32x4*)(kp + 4 * d4);
            const float bs = bias[512 * ch + tid];
#pragma unroll 4
            for (int t = 0; t < 16; ++t) { float a = 0.f;
#pragma unroll
                for (int d4 = 0; d4 < 16; ++d4) { const f32x4 q4 = *(const LAS f32x4*)(qs + t * 64 + 4 * d4); a += (q4[0] * kk[d4][0] + q4[1] * kk[d4][1]) + (q4[2] * kk[d4][2] + q4[3] * kk[d4][3]); }
                a += bs; if (ch == 4 && tid > t) a = -INFINITY;
                S[t * 512 + tid] = a; }
        }
        __syncthreads();
#pragma unroll
        for (int rr = 0; rr < 2; ++rr) { const int t = 2 * wave + rr; float sv[8]; float mx = -INFINITY;
#pragma unroll
            for (int j = 0; j < 8; ++j) { const int col = lane + 64 * j; sv[j] = col < nk ? S[t * 512 + col] : -INFINITY; mx = fmaxf(mx, sv[j]); }
            mx = wave_max(mx);
            const float mo = mrow[t], mn = fmaxf(mo, mx); float sum = 0.f;
#pragma unroll
            for (int j = 0; j < 8; ++j) { const int col = lane + 64 * j; const float p = __builtin_amdgcn_exp2f(sv[j] - mn); if (col < nk) S[t * 512 + col] = p; sum += p; }
            sum = wave_sum(sum);
            if (lane == 0) { const float al = __builtin_amdgcn_exp2f(mo - mn); arow[t] = al; lrow[t] = lrow[t] * al + sum; mrow[t] = mn; } }
        __syncthreads();
        {
#pragma unroll
            for (int t = 0; t < 16; ++t) o[t] *= arow[t];
            const int k0 = 64 * wave;
            if (k0 < nk) { const int kn = nk - k0 < 64 ? nk - k0 : 64;
                const float* vp = ch < 4 ? cvp + (((size_t)b * PAST + 512 * ch + k0) * NH + h) * HD + lane : out_ + O_VS + (((size_t)b * TS + k0) * NH + h) * HD + lane;
                for (int j = 0; j < kn; j += 4) { float vv[4];
#pragma unroll
                    for (int i = 0; i < 4; ++i) vv[i] = vp[(size_t)(j + i) * NH * HD];
#pragma unroll
                    for (int t = 0; t < 16; ++t) { const f32x4 p4 = *(const LAS f32x4*)(S + t * 512 + k0 + j); o[t] += (p4[0] * vv[0] + p4[1] * vv[1]) + (p4[2] * vv[2] + p4[3] * vv[3]); } } }
        }
        __syncthreads();
    }
#pragma unroll
    for (int t = 0; t < 16; ++t) ored[(wave * 16 + t) * 64 + lane] = o[t];
    __syncthreads();
    bf16* A2w = (bf16*)(ws_ + WS_A2);
    for (int e = tid; e < TS * HD; e += NWAVES * 64) { const int t = e >> 6; float s = 0.f;
#pragma unroll
        for (int w = 0; w < NWAVES; ++w) s += ored[w * 1024 + e];
        A2w[((size_t)MP + b * TS + t) * D + h * HD + (e & 63)] = (bf16)f2bf(s / lrow[t]); }
    __syncthreads();
}
struct AttnOrder {
    int vcu, G;
    __device__ __forceinline__ AttnOrder(int grid, int block) : vcu((grid % 8 == 0) ? (block % 8) * (grid / 8) + block / 8 : block), G(grid) {}
    __device__ __forceinline__ bool next(int i, attn_body::AttnUnit& u) const {
        if (G == 256) { if (i >= 4) return false; const int s = vcu & 7; u.bh = vcu >> 3; u.qb = (i == 0) ? s : (i == 1) ? 15 - s : (i == 2) ? 16 + s : 31 - s; return true; }
        const int idx = i * G + vcu; if (idx >= attn_body::BATCH * attn_body::NHEAD * attn_body::NQB) return false; u.bh = idx / attn_body::NQB; u.qb = idx % attn_body::NQB; return true;
    }
    __device__ __forceinline__ void a_ready(const attn_body::AttnUnit&) const {}
    __device__ __forceinline__ void done(const attn_body::AttnUnit&) const {}
};

struct Args { const float* in[N_IN]; float* out; unsigned char* ws; int ph_lo, ph_hi, li, pad; };
__global__ void __launch_bounds__(NWAVES * 64, 2) fox_fwd(Args args) {
    extern __shared__ __attribute__((aligned(16))) unsigned char lds[];
    Frame F;
    F.lds = (LAS unsigned char*)lds;
    F.MISC = (volatile LAS unsigned*)(F.lds + MISC_OFF);
    F.tid = threadIdx.x; F.lane = F.tid & 63; F.wave = __builtin_amdgcn_readfirstlane(F.tid >> 6);
    F.G = gridDim.x; { const int bx = blockIdx.x; F.vcu = (F.G % 8 == 0) ? (bx % 8) * (F.G / 8) + bx / 8 : bx; }
    for (int u = F.tid; u < (LDS_BYTES - LDSCTL_OFF) / 4; u += NWAVES * 64) ((LAS unsigned*)(F.lds + LDSCTL_OFF))[u] = 0u;
    __syncthreads();
    if (N_LAUNCHES == 1) (void)xcd_barrier_post((unsigned*)(WSP() + WS_CTL) + CW_BAR, F.MISC + 8);

#define X ((float*)(WSP() + WS_X))
#define MOD ((float*)(WSP() + WS_MOD))
#define HN ((bf16*)(WSP() + WS_HN))
#define HID ((bf16*)(WSP() + WS_HID))
#define A2 ((bf16*)(WSP() + WS_A2))
    const int lo = args.ph_lo, hi = args.ph_hi;
#define IN(k) (lo <= (k) && (k) < hi)
#define SEAM(k) do { if (IN((k) + 1)) { XcdBarrier bar; bar.bar = (unsigned*)(WSP() + WS_CTL) + CW_BAR; bar.x = xb_xcc_id(); bar.st = F.MISC + 8; xcd_barrier(bar); } } while (0)
#define GEMM_UP(WOFF) do { pg8::Gemm g{HN, (const bf16*)(WSP() + (WOFF)), M, NUP, D}; pg8::StaticOrder S; S.init(M, NUP, F.G, (int)blockIdx.x); pg8::EpiSwiGLU E{HID}; \
        pg8::gemm_phase<pg8::EpiSwiGLU, pg8::StaticOrder, true, true>(F.lds + RING_OFF, g, S, E); } while (0)
#define GEMM_RES(A_, WOFF, K_, BP, BS, CHUNK, COEF) do { pg8::Gemm g{(A_), (const bf16*)(WSP() + (WOFF)), M, D, (K_)}; pg8::StaticOrder S; S.init(M, D, F.G, (int)blockIdx.x); \
        pg8::EpiResid E{(BP), (BS), X, MOD + (CHUNK) * D, (COEF)}; pg8::gemm_phase<pg8::EpiResid, pg8::StaticOrder, true, true>(F.lds + RING_OFF, g, S, E); } while (0)
    if (IN(0)) { p0_prologue(F); SEAM(0); }
    if (IN(1)) { norm_phase<1>(F); SEAM(1); }
    if (IN(2)) { GEMM_UP(WS_WUP1); SEAM(2); }
    if (IN(3)) { GEMM_RES(HID, WS_WDN1, FF, INP(I_XP), INP(I_XS), 2, 0.5f); SEAM(3); }
#ifndef DIS_N2
    if (IN(4)) { norm_phase<2>(F); SEAM(4); }
#endif
    if (IN(5)) {
        for (int b = blockIdx.x; b < NBP; b += F.G) fscan_batch(F, b);
        pg8::Gemm g{HN, (const bf16*)(WSP() + WS_WIN), M, NIN, D}; pg8::StaticOrder S; S.init(M, NIN, F.G, (int)blockIdx.x);
        pg8::EpiIn E{A2, (bf16*)(WSP() + WS_KB), (bf16*)(WSP() + WS_VB), (bf16*)(WSP() + WS_UB), OUTP(), INP(I_GQ), INP(I_GK), attn_body::C2, O_KP, O_VP, O_KS, O_VS, O_CP, O_CS};
        pg8::gemm_phase<pg8::EpiIn, pg8::StaticOrder, true, true>(F.lds + RING_OFF, g, S, E);
        SEAM(5);
    }
    if (IN(6)) {
        const int half = F.G / 2;
        if ((int)blockIdx.x < half) { for (int u = blockIdx.x; u < NBS * NH; u += half) sattn_unit(F, u >> 3, u & 7); }
        else { for (int u = (int)blockIdx.x - half; u < 512 + NBS; u += F.G - half) conv_unit(F, u); }
        const attn_body::AttnTensors AT{(const attn_body::bf16*)A2, (const attn_body::bf16*)(WSP() + WS_KB), (const attn_body::bf16*)(WSP() + WS_VB), (attn_body::bf16*)A2, (const float*)(WSP() + WS_FP)};
        const AttnOrder S((int)F.G, (int)blockIdx.x);
#ifndef DIS_ATTN
        attn_body::attn_phase<AttnOrder>((char*)lds + RING_OFF, AT, S);
#endif
        SEAM(6);
    }
    if (IN(7)) { GEMM_RES(A2, WS_WOUT, D, X, X + (size_t)MP * D, 5, 1.0f); SEAM(7); }
    if (IN(8)) { norm_phase<3>(F); SEAM(8); }
    if (IN(9)) { GEMM_UP(WS_WUP2); SEAM(9); }
    if (IN(10)) { GEMM_RES(HID, WS_WDN2, FF, X, X + (size_t)MP * D, 8, 0.5f); SEAM(10); }
    if (IN(11)) { norm_phase<4>(F); }
#undef IN
#undef SEAM
#undef X
#undef MOD
#undef HN
#undef HID
#undef A2
}

extern "C" void kernel_launch(void* const* d_in, const int* in_sizes, int n_in, void* d_out, int out_size, void* d_ws, size_t ws_size, hipStream_t stream) {
    static int grid = 0;
    if (grid == 0) {
        if (n_in != N_IN || in_sizes[0] != MP * D || (size_t)out_size != O_END || ws_size < WS_END) { fprintf(stderr, "kernel_launch: unexpected shapes (n_in %d, in0 %d, out %d, ws %zu); nothing launched\n", n_in, n_in > 0 ? in_sizes[0] : -1, out_size, ws_size); grid = -1; return; }
        int dev = 0, cus = 0, per_cu = 0;
        if (hipGetDevice(&dev) != hipSuccess || hipDeviceGetAttribute(&cus, hipDeviceAttributeMultiprocessorCount, dev) != hipSuccess) { fprintf(stderr, "kernel_launch: device query failed\n"); grid = -1; return; }
        if (hipFuncSetAttribute((const void*)fox_fwd, hipFuncAttributeMaxDynamicSharedMemorySize, LDS_BYTES) != hipSuccess) { fprintf(stderr, "kernel_launch: hipFuncSetAttribute failed\n"); grid = -1; return; }
        if (hipOccupancyMaxActiveBlocksPerMultiprocessor(&per_cu, (const void*)fox_fwd, NWAVES * 64, LDS_BYTES) != hipSuccess || per_cu < 1) { fprintf(stderr, "kernel_launch: occupancy query reports %d workgroups per CU; nothing launched\n", per_cu); (void)hipGetLastError(); grid = -1; return; }
        grid = cus;
    }
    if (grid < 0) return;
    if (hipMemsetAsync((char*)d_ws + WS_CTL, 0, CTL_ZERO_BYTES, stream) != hipSuccess) { fprintf(stderr, "kernel_launch: memset failed\n"); return; }
    Args a{};
    for (int i = 0; i < N_IN; ++i) a.in[i] = (const float*)d_in[i];
    a.out = (float*)d_out; a.ws = (unsigned char*)d_ws;
    if (N_LAUNCHES == 1) {
        a.ph_lo = 0; a.ph_hi = N_PHASES; a.li = 0;
        void* kargs[] = {&a};
        const hipError_t le = hipLaunchCooperativeKernel((const void*)fox_fwd, dim3(grid), dim3(NWAVES * 64), kargs, LDS_BYTES, stream);
        if (le != hipSuccess) fprintf(stderr, "kernel_launch: cooperative launch failed: %s (grid %d)\n", hipGetErrorName(le), grid);
    } else {
        for (int li = 0; li < N_PHASES; ++li) { a.ph_lo = li; a.ph_hi = li + 1; a.li = li;
            hipLaunchKernelGGL(fox_fwd, dim3(grid), dim3(NWAVES * 64), LDS_BYTES, stream, a);
            const hipError_t le = hipPeekAtLastError(); if (le != hipSuccess) { fprintf(stderr, "kernel_launch: launch %d failed: %s\n", li, hipGetErrorName(le)); break; } }
    }
}
```

```cpp
#include <hip/hip_runtime.h>
#include <hip/hip_bf16.h>
#include <cstdio>
#include <cstdint>
#include <cmath>
template <int CTRL> __device__ __forceinline__ float wr_dpp(float v) { return __builtin_bit_cast(float, __builtin_amdgcn_update_dpp(0, __builtin_bit_cast(int, v), CTRL, 0xf, 0xf, true)); }
__device__ __forceinline__ float row_sum16(float v) { v += wr_dpp<0xb1>(v); v += wr_dpp<0x4e>(v); v += wr_dpp<0x124>(v); v += wr_dpp<0x128>(v); return v; }
__device__ __forceinline__ float row_max16(float v) { v = fmaxf(v, wr_dpp<0xb1>(v)); v = fmaxf(v, wr_dpp<0x4e>(v)); v = fmaxf(v, wr_dpp<0x124>(v)); v = fmaxf(v, wr_dpp<0x128>(v)); return v; }
#define WR_SWAP16(a, b) asm volatile("s_nop 1\n\tv_permlane16_swap_b32 %0, %1" : "+v"(a), "+v"(b))
#define WR_SWAP32(a, b) asm volatile("s_nop 1\n\tv_permlane32_swap_b32 %0, %1" : "+v"(a), "+v"(b))
__device__ __forceinline__ float xsum16(float v) { float a = v, b = v; WR_SWAP16(a, b); return a + b; }
__device__ __forceinline__ float xsum32(float v) { float a = v, b = v; WR_SWAP32(a, b); return a + b; }
__device__ __forceinline__ float xmax16(float v) { float a = v, b = v; WR_SWAP16(a, b); return fmaxf(a, b); }
__device__ __forceinline__ float xmax32(float v) { float a = v, b = v; WR_SWAP32(a, b); return fmaxf(a, b); }
namespace pg8 {
#define PG8_LAS __attribute__((address_space(3)))
typedef unsigned short bf16_t;
typedef short bf16x8 __attribute__((ext_vector_type(8)));
typedef float f32x4 __attribute__((ext_vector_type(4)));
typedef unsigned u32x4 __attribute__((ext_vector_type(4)));
constexpr int BM = 256, BK = 64, HALF = 128, HTB = HALF * BK * 2  , STAGE_BYTES = 8 * HTB, NXCD = 8, WGM = 8;

__host__ __device__ __forceinline__ int lds_byte(int r, int c) { const int st = (r >> 4) * 2 + (c >> 5), rr = r & 15, cc = c & 31, ob = rr * 64 + cc * 2; return st * 1024 + (ob ^ (((ob >> 9) & 1) << 5)); }
__host__ __device__ __forceinline__ void stage_rc(int b, int& R, int& C) { const int st = b / 1024, sb = b % 1024, swz = sb ^ (((sb >> 9) & 1) << 5); R = (st >> 1) * 16 + swz / 64; C = (st & 1) * 32 + (swz % 64) / 2; }
__host__ __device__ __forceinline__ int perm32(int rho) { const int n = rho >> 4, i = rho & 15; return 8 * (i >> 2) + 4 * n + (i & 3); }

struct Unit { int pm, pn, kb, nt, piece; };
struct Gemm { const bf16_t* A; const bf16_t* Bt; int M, N, K; };

struct StaticOrder {
    int nM, nN, nwg, G, c, ntk;
    __host__ __device__ __forceinline__ void init(int M, int N, int G_, int c_, int ntk_) { nM = M / BM; nN = N / BM; nwg = nM * nN; G = G_; c = c_; ntk = ntk_; }
    __host__ __device__ __forceinline__ bool next(int i, Unit& u) const {
        const long L = (long)i * G + c; if (L >= nwg) { u.pm = 0; u.pn = 0; u.kb = 0; u.nt = ntk; u.piece = 0; return false; }
        int wgid = (int)L; { const int q = nwg / NXCD, r = nwg % NXCD, xcd = wgid % NXCD, off = wgid / NXCD; wgid = (xcd < r ? xcd * (q + 1) : r * (q + 1) + (xcd - r) * q) + off; }
        const int nig = WGM * nN, gid = wgid / nig, fm = gid * WGM, gsz = (nM - fm) < WGM ? (nM - fm) : WGM;
        u.pm = fm + ((wgid % nig) % gsz); u.pn = (wgid % nig) / gsz; u.kb = 0; u.nt = ntk; u.piece = 0; return true;
    }
    __device__ __forceinline__ void a_ready(const Unit&) const {}
    __device__ __forceinline__ void done(const Unit&) const {}
};

struct OneUnit {
    int pm, pn, ntk;
    __host__ __device__ __forceinline__ bool next(int i, Unit& u) const { u.pm = pm; u.pn = pn; u.kb = 0; u.nt = ntk; u.piece = 0; return i == 0; }
    __device__ __forceinline__ void a_ready(const Unit&) const {}
    __device__ __forceinline__ void done(const Unit&) const {}
};
struct PieceOrder {
    int pm, nN, np, ntp, c;
    __host__ __device__ __forceinline__ bool next(int i, Unit& u) const { u.pm = pm; u.pn = c % nN; u.piece = c / nN; u.kb = (c / nN) * ntp * BK * 2; u.nt = ntp; return i == 0 && c < nN * np; }
    __device__ __forceinline__ void a_ready(const Unit&) const {}
    __device__ __forceinline__ void done(const Unit&) const {}
};
struct SplitOrder {
    StaticOrder base; int np, ntp;
    __host__ __device__ __forceinline__ void init(int Mp, int N, int G_, int c_, int ntk_, int ntp_) { base.init(Mp, N, G_, c_, ntk_); ntp = ntp_; np = ntk_ / ntp_; }
    __host__ __device__ __forceinline__ bool next(int i, Unit& u) const {
        const long L = (long)i * base.G + base.c; Unit a = {0, 0, 0, 0, 0}; const bool okp = base.next(i, a);
        const int sp = (int)(L - base.nwg), piece = sp / base.nN; const bool oks = !okp && piece < np;
        u.pm = okp ? a.pm : base.nM; u.pn = okp ? a.pn : sp % base.nN; u.kb = okp ? 0 : piece * ntp * BK * 2; u.nt = okp ? base.ntk : (piece == np - 1 ? base.ntk - (np - 1) * ntp : ntp); u.piece = okp ? 0 : piece;
        return okp || oks;
    }
    __device__ __forceinline__ void a_ready(const Unit&) const {}
    __device__ __forceinline__ void done(const Unit&) const {}
};
__device__ __forceinline__ unsigned cvt_pk_bf16(float lo, float hi) { unsigned r; asm volatile("v_cvt_pk_bf16_f32 %0, %1, %2" : "=v"(r) : "v"(lo), "v"(hi)); return r; }
typedef float f32x2 __attribute__((ext_vector_type(2)));
constexpr int EP_MODW = 9216;
__device__ __forceinline__ int ep_batch(int pm, int ai, int wr, int m) { return pm < 128 ? (pm >> 5) : (4 + 8 * ai + 4 * wr + m); }
__device__ __forceinline__ float ep_silu(float x) { return x * __builtin_amdgcn_rcpf(1.0f + __builtin_amdgcn_exp2f(-1.4426950408889634f * x)); }
__device__ __forceinline__ float ep_sigmoid(float x) { return __builtin_amdgcn_rcpf(1.0f + __builtin_amdgcn_exp2f(-1.4426950408889634f * x)); }

struct EpiSwiGLU {
    static constexpr bool PERM = true, AFTER_DRAIN = false;
    unsigned char* O; float s;
    __device__ __forceinline__ void operator()(f32x4 (&acc)[2][2][4][2], const Unit& u, int wr, int wc, int fr_, int fq_) const {
        int fr = fr_, fq = fq_; asm volatile("" : "+v"(fr), "+v"(fq));
        const int row0 = u.pm * BM + wr * 64 + fr, col0 = u.pn * 128 + wc * 32 + 8 * fq;
#pragma unroll
        for (int ai = 0; ai < 2; ++ai)
#pragma unroll
            for (int m = 0; m < 4; ++m) { unsigned char* rowp = O + (size_t)(row0 + ai * HALF + m * 16) * 2816 + col0;
                typedef float f32x2_t __attribute__((ext_vector_type(2)));
                const float c1 = -1.4426950408889634f * s, is2 = 1.0f / (s * s);
                f32x2_t h2[4];
#pragma unroll
                for (int n = 0; n < 2; ++n)
#pragma unroll
                    for (int i = 0; i < 4; i += 2) { const f32x2_t a = {acc[ai][0][m][n][i], acc[ai][0][m][n][i + 1]}, b = {acc[ai][1][m][n][i], acc[ai][1][m][n][i + 1]};
                        f32x2_t e = a * c1; e.x = __builtin_amdgcn_exp2f(e.x); e.y = __builtin_amdgcn_exp2f(e.y);
                        f32x2_t d = e * is2 + is2; d.x = __builtin_amdgcn_rcpf(d.x); d.y = __builtin_amdgcn_rcpf(d.y);
                        h2[2 * n + (i >> 1)] = (a * b) * d; }
                int w0 = __builtin_bit_cast(int, h2[0].x), w1 = __builtin_bit_cast(int, h2[2].x);
                w0 = __builtin_amdgcn_cvt_pk_fp8_f32(h2[0].x, h2[0].y, w0, false); w0 = __builtin_amdgcn_cvt_pk_fp8_f32(h2[1].x, h2[1].y, w0, true); w1 = __builtin_amdgcn_cvt_pk_fp8_f32(h2[2].x, h2[2].y, w1, false); w1 = __builtin_amdgcn_cvt_pk_fp8_f32(h2[3].x, h2[3].y, w1, true);
                typedef unsigned u32x2_t __attribute__((ext_vector_type(2))); *(u32x2_t*)rowp = (u32x2_t){(unsigned)w0, (unsigned)w1}; }
    }
};
__device__ __forceinline__ f32x4 ep_bf_lo(unsigned a, unsigned b) { f32x4 r; r[0] = __builtin_bit_cast(float, a << 16); r[1] = __builtin_bit_cast(float, a & 0xffff0000u); r[2] = __builtin_bit_cast(float, b << 16); r[3] = __builtin_bit_cast(float, b & 0xffff0000u); return r; }
template <bool BASE_BF16> struct EpiResid {
    static constexpr bool PERM = true, AFTER_DRAIN = false;
    const void* base_p; bf16_t* out; const float* gate; float coef; float* part;
    __device__ __forceinline__ void operator()(f32x4 (&acc)[2][2][4][2], const Unit& u, int wr, int wc, int fr_, int fq_) const {
        int fr = fr_, fq = fq_; asm volatile("" : "+v"(fr), "+v"(fq));
        const unsigned coff = (unsigned)(u.pn * BM + wc * 32 + 8 * fq), off0 = (unsigned)((wr * 64 + fr) * 1024) + coff;
        if (u.pm >= 128) {
            float* o = part + (size_t)u.piece * BM * 1024;
#pragma unroll
            for (int ai = 0; ai < 2; ++ai)
#pragma unroll
                for (int m = 0; m < 4; ++m) { const unsigned offr = off0 + (unsigned)((ai * HALF + m * 16) * 1024); const float* g = gate + (size_t)ep_batch(u.pm, ai, wr, m) * EP_MODW;
#pragma unroll
                    for (int bj = 0; bj < 2; ++bj)
#pragma unroll
                        for (int n = 0; n < 2; ++n) { const unsigned c = (unsigned)(bj * HALF + n * 4); *(f32x4*)(o + (offr + c)) = (*(const f32x4*)(g + (coff + c)) * coef) * acc[ai][bj][m][n]; } }
            return;
        }
        const char* base = (const char*)base_p + (size_t)u.pm * BM * 1024 * (BASE_BF16 ? 2 : 4); char* o = (char*)(out + (size_t)u.pm * BM * 1024); const char* g = (const char*)(gate + (size_t)(u.pm >> 5) * EP_MODW);
        const unsigned vb = off0 * (BASE_BF16 ? 2u : 4u), vo = off0 * 2u, vc = coff * 4u;
        f32x4 bs[2][2][2];
        u32x4 bb[2][2];
#define ER_LOADQ(q_) do { _Pragma("unroll") for (int mm = 0; mm < 2; ++mm) _Pragma("unroll") for (int bj = 0; bj < 2; ++bj) { const int ro_ = (((q_) >> 1) * HALF + (((q_) & 1) * 2 + mm) * 16) * 1024 + bj * HALF; \
            if (BASE_BF16) bb[mm][bj] = *(const u32x4*)(base + ro_ * 2 + vb); else { bs[mm][bj][0] = __builtin_nontemporal_load((const f32x4*)(base + ro_ * 4 + vb)); bs[mm][bj][1] = __builtin_nontemporal_load((const f32x4*)(base + (ro_ + 4) * 4 + vb)); } } } while (0)
        {
            f32x4 gv[2][2];
#pragma unroll
            for (int bj = 0; bj < 2; ++bj)
#pragma unroll
                for (int n = 0; n < 2; ++n) gv[bj][n] = *(const f32x4*)(g + (bj * HALF + n * 4) * 4 + vc);
            ER_LOADQ(0);
            asm volatile("" ::: "memory");
#pragma unroll
            for (int ai = 0; ai < 2; ++ai)
#pragma unroll
                for (int m = 0; m < 4; ++m)
#pragma unroll
                    for (int bj = 0; bj < 2; ++bj)
#pragma unroll
                        for (int n = 0; n < 2; ++n) acc[ai][bj][m][n] = (gv[bj][n] * coef) * acc[ai][bj][m][n];
        }
#pragma unroll
        for (int q = 0; q < 4; ++q) {
            const int ai = q >> 1, m0 = (q & 1) * 2;
            u32x4 ow[2][2];
#pragma unroll
            for (int mm = 0; mm < 2; ++mm)
#pragma unroll
                for (int bj = 0; bj < 2; ++bj) { f32x4 x0, x1;
                    if (BASE_BF16) { x0 = acc[ai][bj][m0 + mm][0] + ep_bf_lo(bb[mm][bj][0], bb[mm][bj][1]); x1 = acc[ai][bj][m0 + mm][1] + ep_bf_lo(bb[mm][bj][2], bb[mm][bj][3]); }
                    else { x0 = acc[ai][bj][m0 + mm][0] + bs[mm][bj][0]; x1 = acc[ai][bj][m0 + mm][1] + bs[mm][bj][1]; }
                    ow[mm][bj][0] = cvt_pk_bf16(x0[0], x0[1]); ow[mm][bj][1] = cvt_pk_bf16(x0[2], x0[3]); ow[mm][bj][2] = cvt_pk_bf16(x1[0], x1[1]); ow[mm][bj][3] = cvt_pk_bf16(x1[2], x1[3]); }
            asm volatile("" ::: "memory");
            if (q < 3) ER_LOADQ(q + 1);
            asm volatile("" ::: "memory");
#pragma unroll
            for (int mm = 0; mm < 2; ++mm)
#pragma unroll
                for (int bj = 0; bj < 2; ++bj) *(u32x4*)(o + ((ai * HALF + (m0 + mm) * 16) * 1024 + bj * HALF) * 2 + vo) = ow[mm][bj];
            asm volatile("" ::: "memory");
        }
#undef ER_LOADQ
    }
};
struct EpiPart {
    static constexpr bool PERM = true, AFTER_DRAIN = false;
    float* P; int ld;
    __device__ __forceinline__ void operator()(f32x4 (&acc)[2][2][4][2], const Unit& u, int wr, int wc, int fr_, int fq_) const {
        int fr = fr_, fq = fq_; asm volatile("" : "+v"(fr), "+v"(fq));
        float* o = P + (size_t)u.piece * BM * ld + (size_t)(wr * 64 + fr) * ld + u.pn * BM + wc * 32 + 8 * fq;
#pragma unroll
        for (int ai = 0; ai < 2; ++ai)
#pragma unroll
            for (int m = 0; m < 4; ++m)
#pragma unroll
                for (int bj = 0; bj < 2; ++bj)
#pragma unroll
                    for (int n = 0; n < 2; ++n) *(f32x4*)(o + (size_t)(ai * HALF + m * 16) * ld + bj * HALF + n * 4) = acc[ai][bj][m][n];
    }
};
struct EpiIn {
    static constexpr bool PERM = true, AFTER_DRAIN = false;
    bf16_t *A2, *KB, *VB, *UB; float* dout; const float *gq, *gk; float c2;
    size_t o_kp, o_vp, o_ks, o_vs, o_cp, o_cs; int probe;
    __device__ __forceinline__ void operator()(f32x4 (&acc)[2][2][4][2], const Unit& u, int wr, int wc, int fr_, int fq_) const {
        int fr = fr_, fq = fq_; asm volatile("" : "+v"(fr), "+v"(fq));
        if (probe == 3) { if (acc[0][0][0][0][0] == 12345.678f) dout[fr] = acc[1][1][3][1][3]; return; }
        const int pn = u.pn; const bool smp = u.pm >= 128;
        const size_t trow = (size_t)u.pm * BM, srow = smp ? 0 : trow;
        const unsigned rl0 = (unsigned)(wr * 64 + fr);
        if (pn < 6) {
            const int sec = pn >> 1, head = 4 * (pn & 1) + wc;
            if (sec < 2) {
                f32x4 g[2][2];
#pragma unroll
                for (int bj = 0; bj < 2; ++bj)
#pragma unroll
                    for (int n = 0; n < 2; ++n) g[bj][n] = *(const f32x4*)((sec == 0 ? gq : gk) + 32 * bj + 8 * fq + 4 * n) * (sec == 0 ? c2 : 1.0f);
                asm volatile("s_waitcnt vmcnt(0)" : "+v"(g[0][0]), "+v"(g[0][1]), "+v"(g[1][0]), "+v"(g[1][1]) :: "memory");
#pragma unroll
                for (int ai = 0; ai < 2; ++ai)
#pragma unroll
                    for (int m = 0; m < 4; ++m) { float ss = 0.f;
#pragma unroll
                        for (int bj = 0; bj < 2; ++bj)
#pragma unroll
                            for (int n = 0; n < 2; ++n) { const f32x4 v = acc[ai][bj][m][n]; ss += (v[0] * v[0] + v[1] * v[1]) + (v[2] * v[2] + v[3] * v[3]); }
                        ss = xsum32(xsum16(ss));
                        const float r = __builtin_amdgcn_rsqf(ss * (1.0f / 64.0f) + 1e-6f);
#pragma unroll
                        for (int bj = 0; bj < 2; ++bj)
#pragma unroll
                            for (int n = 0; n < 2; ++n) acc[ai][bj][m][n] = acc[ai][bj][m][n] * r * g[bj][n]; }
            }
            const size_t kvd = (size_t)(VB - KB), sel = (size_t)(sec == 2 ? 1 : 0);
            bf16_t* db = (sec == 0 ? A2 + trow * 1024 : KB + sel * kvd + trow * 512) + head * 64 + 8 * fq;
            const unsigned pitch = sec == 0 ? 1024u : 512u;
            float* df = dout + (smp ? o_ks + sel * (o_vs - o_ks) : o_kp + sel * (o_vp - o_kp)) + srow * 512 + head * 64 + 8 * fq;
#pragma unroll
            for (int ai = 0; ai < 2; ++ai)
#pragma unroll
                for (int m = 0; m < 4; ++m) { const unsigned rl = rl0 + (unsigned)(ai * HALF + m * 16);
#pragma unroll
                    for (int bj = 0; bj < 2; ++bj) { const f32x4 a = acc[ai][bj][m][0], b = acc[ai][bj][m][1]; u32x4 w; w.x = cvt_pk_bf16(a[0], a[1]); w.y = cvt_pk_bf16(a[2], a[3]); w.z = cvt_pk_bf16(b[0], b[1]); w.w = cvt_pk_bf16(b[2], b[3]);
                        if (probe < 2) *(u32x4*)(db + (rl * pitch + (unsigned)(32 * bj))) = w;
                        if (sec != 0 && probe < 1) { __builtin_nontemporal_store(a, (f32x4*)(df + (rl * 512u + (unsigned)(32 * bj)))); __builtin_nontemporal_store(b, (f32x4*)(df + (rl * 512u + (unsigned)(32 * bj + 4)))); } } }
        } else {
            const int c0 = 128 * (pn - 6) + wc * 32 + 8 * fq;
            bf16_t* ub = UB + trow * 512 + c0;
            const bool tail = !smp && (u.pm & 31) == 31;
#pragma unroll
            for (int ai = 0; ai < 2; ++ai)
#pragma unroll
                for (int m = 0; m < 4; ++m) { const unsigned rl = rl0 + (unsigned)(ai * HALF + m * 16);
                    f32x4 uu[2];
#pragma unroll
                    for (int n = 0; n < 2; ++n)
#pragma unroll
                        for (int i = 0; i < 4; ++i) uu[n][i] = acc[ai][0][m][n][i] * ep_sigmoid(acc[ai][1][m][n][i]);
                    u32x4 w; w.x = cvt_pk_bf16(uu[0][0], uu[0][1]); w.y = cvt_pk_bf16(uu[0][2], uu[0][3]); w.z = cvt_pk_bf16(uu[1][0], uu[1][1]); w.w = cvt_pk_bf16(uu[1][2], uu[1][3]);
                    if (probe < 2) *(u32x4*)(ub + rl * 512u) = w;
                    if (smp) { float* d = dout + o_cs + ((size_t)(rl >> 4) * 30 + 14 + (rl & 15)) * 512 + c0; *(f32x4*)d = uu[0]; *(f32x4*)(d + 4) = uu[1]; }
                    else if (tail && ai == 1 && m >= 2) { if (rl >= 226u) { float* d = dout + o_cp + ((size_t)(u.pm >> 5) * 30 + (rl - 226u)) * 512 + c0; *(f32x4*)d = uu[0]; *(f32x4*)(d + 4) = uu[1]; } } }
        }
    }
};

#if defined(PROBE_NULLEPI) || defined(PROBE_NULLIN)
struct EpiNull {
    static constexpr bool PERM = true, AFTER_DRAIN = false;
    float* O;
    __device__ __forceinline__ void operator()(f32x4 (&acc)[2][2][4][2], const Unit& u, int wr, int wc, int fr_, int fq_) const {
        int fr = fr_, fq = fq_; asm volatile("" : "+v"(fr), "+v"(fq));
        f32x4 s = (f32x4){0.f, 0.f, 0.f, 0.f};
#pragma unroll
        for (int ai = 0; ai < 2; ++ai)
#pragma unroll
            for (int bj = 0; bj < 2; ++bj)
#pragma unroll
                for (int m = 0; m < 4; ++m)
#pragma unroll
                    for (int n = 0; n < 2; ++n) s += acc[ai][bj][m][n];
        if (s[0] + s[1] + s[2] + s[3] == 12345.678f) O[u.pm * 256 + wr * 64 + fr] = s[0];
    }
};
#endif
typedef int v4i_t __attribute__((ext_vector_type(4))); typedef int v8i_t __attribute__((ext_vector_type(8)));
__device__ __forceinline__ v8i_t cat8(bf16x8 lo, bf16x8 hi) { return __builtin_shufflevector(__builtin_bit_cast(v4i_t, lo), __builtin_bit_cast(v4i_t, hi), 0, 1, 2, 3, 4, 5, 6, 7); }
__device__ __forceinline__ void glds_sv(const void* sbase_, unsigned voff, unsigned ldsaddr) { unsigned keep;
    const unsigned long long sb_ = (unsigned long long)(uintptr_t)sbase_;
    const void* sbase = (const void*)(uintptr_t)(((unsigned long long)(unsigned)__builtin_amdgcn_readfirstlane((int)(sb_ >> 32)) << 32) | (unsigned)__builtin_amdgcn_readfirstlane((int)(unsigned)sb_));
    asm volatile("s_mov_b32 %0, m0\n\ts_mov_b32 m0, %3\n\ts_nop 0\n\tglobal_load_lds_dwordx4 %1, %2\n\ts_mov_b32 m0, %0" : "=&s"(keep) : "v"(voff), "s"(sbase), "s"(ldsaddr) : "memory"); }
template <class Epi, class Sched, bool ALIGN_EPI = false, bool SP2 = false, bool FP8 = false>
__device__ __forceinline__ void gemm_phase(PG8_LAS unsigned char* lds, const Gemm g, const Sched& S, const Epi& E) {
    const int tid = threadIdx.x, wid = __builtin_amdgcn_readfirstlane(tid >> 6), lane = tid & 63, wr = wid >> 2, wc = wid & 3, fr = lane & 15, fq = lane >> 4;
    const int K = g.K; constexpr int ES = FP8 ? 1 : 2;
    unsigned voffA[2], voffB[2];
#pragma unroll
    for (int i = 0; i < 2; ++i) { int R, C; stage_rc(tid * 16 + i * 8192, R, C); const int Rb = Epi::PERM ? ((R & ~31) + perm32(R & 31)) : R;
        voffA[i] = (unsigned)(R * K * ES + C * 2); voffB[i] = (unsigned)(Rb * K * ES + C * 2); }
    const size_t kstep = (size_t)(BK * 2);
    const size_t hstep = (size_t)HALF * K * ES;
    const size_t tstep = 2 * hstep;
    const unsigned ldsw = (unsigned)wid * 1024u, ldsb = (unsigned)(uintptr_t)lds;
    const int aoff = lds_byte(wr * 64 + fr, fq * 8), boff = lds_byte(wc * 32 + fr, fq * 8);
#define PG8_SA(b, h) (((b) * 2 + (h)) * HTB)
#define PG8_SB(b, h) ((4 + (b) * 2 + (h)) * HTB)
#define PG8_STAGE(bufoff, gbase, voff) do { _Pragma("unroll") for (int _i = 0; _i < 2; ++_i) glds_sv((gbase), (voff)[_i], ldsb + (unsigned)(bufoff) + ldsw + _i * 8192u); } while (0)
#define PG8_LDA(dst, b, h) do { _Pragma("unroll") for (int m = 0; m < 4; ++m) dst[m] = cat8(*(const PG8_LAS bf16x8*)(lds + PG8_SA(b, h) + aoff + m * 2048), *(const PG8_LAS bf16x8*)(lds + PG8_SA(b, h) + aoff + m * 2048 + 1024)); } while (0)
#define PG8_LDB(dst, b, h) do { _Pragma("unroll") for (int n = 0; n < 2; ++n) dst[n] = cat8(*(const PG8_LAS bf16x8*)(lds + PG8_SB(b, h) + boff + n * 2048), *(const PG8_LAS bf16x8*)(lds + PG8_SB(b, h) + boff + n * 2048 + 1024)); } while (0)
#define PG8_HALF(x, k) __builtin_bit_cast(bf16x8, (k) == 0 ? __builtin_shufflevector(x, x, 0, 1, 2, 3) : __builtin_shufflevector(x, x, 4, 5, 6, 7))
#define PG8_MMA(ai, bj, At, Bt) do { __builtin_amdgcn_s_setprio(1); _Pragma("unroll") for (int m = 0; m < 4; ++m) _Pragma("unroll") for (int n = 0; n < 2; ++n) { \
        if constexpr (FP8) { acc[ai][bj][m][n] = __builtin_amdgcn_mfma_scale_f32_16x16x128_f8f6f4(Bt[n], At[m], acc[ai][bj][m][n], 0, 0, 0, 0, 0, 0); }     \
        else { _Pragma("unroll") for (int k = 0; k < 2; ++k) acc[ai][bj][m][n] = __builtin_amdgcn_mfma_f32_16x16x32_bf16(PG8_HALF(Bt[n], k), PG8_HALF(At[m], k), acc[ai][bj][m][n], 0, 0, 0); } } __builtin_amdgcn_s_setprio(0); } while (0)
#define PG8_UNI(u_) do { (u_).pm = __builtin_amdgcn_readfirstlane((u_).pm); (u_).pn = __builtin_amdgcn_readfirstlane((u_).pn); (u_).kb = __builtin_amdgcn_readfirstlane((u_).kb); (u_).nt = __builtin_amdgcn_readfirstlane((u_).nt); (u_).piece = __builtin_amdgcn_readfirstlane((u_).piece); } while (0)
#define PG8_WAIT_V(n) asm volatile("s_waitcnt vmcnt(" #n ")" ::: "memory")
#define PG8_WAIT_L(n) asm volatile("s_waitcnt lgkmcnt(" #n ")" ::: "memory")
#define PG8_BAR __builtin_amdgcn_s_barrier()
#define PG8_SCHED __builtin_amdgcn_sched_barrier(0)
    Unit cur = {0, 0, 0, 0, 0}, nxt = {0, 0, 0, 0, 0}; int ui = 0;
    if (!S.next(0, cur)) return;
    PG8_UNI(cur);
    f32x4 acc[2][2][4][2];
#pragma unroll
    for (int a = 0; a < 2; ++a)
#pragma unroll
        for (int b = 0; b < 2; ++b)
#pragma unroll
            for (int m = 0; m < 4; ++m)
#pragma unroll
                for (int n = 0; n < 2; ++n) acc[a][b][m][n] = (f32x4){0.f, 0.f, 0.f, 0.f};
    v8i_t At[4], B0[2], B1[2];
    const char* cA = (const char*)g.A + (size_t)cur.pm * tstep + cur.kb; const char* cB = (const char*)g.Bt + (size_t)cur.pn * tstep + cur.kb;
    S.a_ready(cur);
    if constexpr (SP2) {
        PG8_STAGE(PG8_SB(0, 0), cB, voffB); PG8_STAGE(PG8_SB(0, 1), cB + hstep, voffB); PG8_STAGE(PG8_SA(0, 0), cA, voffA); PG8_STAGE(PG8_SA(0, 1), cA + hstep, voffA);
        if (wr == 1) PG8_BAR;
        PG8_WAIT_V(2); PG8_BAR;
        PG8_STAGE(PG8_SB(1, 0), cB + kstep, voffB); PG8_STAGE(PG8_SA(1, 0), cA + kstep, voffA); PG8_STAGE(PG8_SB(1, 1), cB + hstep + kstep, voffB);
        PG8_WAIT_V(6); PG8_BAR;
    } else {
        PG8_STAGE(PG8_SB(0, 0), cB, voffB); PG8_STAGE(PG8_SA(0, 0), cA, voffA); PG8_STAGE(PG8_SB(0, 1), cB + hstep, voffB); PG8_STAGE(PG8_SA(0, 1), cA + hstep, voffA);
        if (wr == 1) PG8_BAR;
        PG8_WAIT_V(4); PG8_BAR;
        PG8_STAGE(PG8_SB(1, 0), cB + kstep, voffB); PG8_STAGE(PG8_SA(1, 0), cA + kstep, voffA); PG8_STAGE(PG8_SB(1, 1), cB + hstep + kstep, voffB);
        PG8_WAIT_V(6); PG8_BAR;
    }
    for (;;) {
        const bool has_next = __builtin_amdgcn_readfirstlane((int)S.next(ui + 1, nxt)) != 0; PG8_UNI(nxt);
        const char* nA = has_next ? (const char*)g.A + (size_t)nxt.pm * tstep + nxt.kb : cA; const char* nB = has_next ? (const char*)g.Bt + (size_t)nxt.pn * tstep + nxt.kb : cB;
        const int nt = cur.nt;
        for (int t = 0; t < nt; t += 2) {
            const bool last = (t == nt - 2);
            const char* a1 = cA + (size_t)(t + 1) * kstep;
            const char* a2 = last ? nA : cA + (size_t)(t + 2) * kstep; const char* b2 = last ? nB : cB + (size_t)(t + 2) * kstep;
            const char* a3 = a2 + kstep; const char* b3 = b2 + kstep;
            if (last && has_next) S.a_ready(nxt);
            if constexpr (SP2) {
            PG8_LDB(B0, 0, 0); PG8_LDB(B1, 0, 1); PG8_SCHED; PG8_LDA(At, 0, 0); PG8_STAGE(PG8_SA(1, 1), a1 + hstep, voffA);
            PG8_WAIT_V(8); PG8_WAIT_L(0); PG8_BAR; PG8_MMA(0, 0, At, B0); PG8_MMA(0, 1, At, B1); PG8_BAR; PG8_SCHED;
            PG8_LDA(At, 0, 1); PG8_STAGE(PG8_SB(0, 0), b2, voffB); PG8_STAGE(PG8_SB(0, 1), b2 + hstep, voffB); PG8_STAGE(PG8_SA(0, 0), a2, voffA);
            PG8_WAIT_V(8); PG8_WAIT_L(0); PG8_BAR; PG8_MMA(1, 0, At, B0); PG8_MMA(1, 1, At, B1); PG8_BAR; PG8_SCHED;
            PG8_LDB(B0, 1, 0); PG8_LDB(B1, 1, 1); PG8_SCHED; PG8_LDA(At, 1, 0); PG8_STAGE(PG8_SA(0, 1), a2 + hstep, voffA);
            PG8_WAIT_V(8); PG8_WAIT_L(0); PG8_BAR; PG8_MMA(0, 0, At, B0); PG8_MMA(0, 1, At, B1); PG8_BAR; PG8_SCHED;
            PG8_LDA(At, 1, 1); PG8_STAGE(PG8_SB(1, 0), b3, voffB); PG8_STAGE(PG8_SB(1, 1), b3 + hstep, voffB); PG8_STAGE(PG8_SA(1, 0), a3, voffA);
            PG8_WAIT_V(8); PG8_WAIT_L(0); PG8_BAR; PG8_MMA(1, 0, At, B0); PG8_MMA(1, 1, At, B1); PG8_BAR; PG8_SCHED;
            } else {
            PG8_LDB(B0, 0, 0); PG8_SCHED; PG8_LDA(At, 0, 0); PG8_STAGE(PG8_SA(1, 1), a1 + hstep, voffA);
            PG8_WAIT_L(8); PG8_BAR; PG8_WAIT_L(0); PG8_MMA(0, 0, At, B0); PG8_BAR; PG8_SCHED;
            PG8_LDB(B1, 0, 1); PG8_STAGE(PG8_SB(0, 0), b2, voffB);
            PG8_BAR; PG8_WAIT_L(0); PG8_MMA(0, 1, At, B1); PG8_BAR;
            PG8_LDA(At, 0, 1); PG8_STAGE(PG8_SA(0, 0), a2, voffA);
            PG8_BAR; PG8_WAIT_L(0); PG8_MMA(1, 0, At, B0); PG8_BAR; PG8_SCHED;
            PG8_STAGE(PG8_SB(0, 1), b2 + hstep, voffB);
            PG8_WAIT_V(6); PG8_BAR; PG8_MMA(1, 1, At, B1); PG8_BAR;
            PG8_LDB(B0, 1, 0); PG8_SCHED; PG8_LDA(At, 1, 0); PG8_STAGE(PG8_SA(0, 1), a2 + hstep, voffA);
            PG8_WAIT_L(8); PG8_BAR; PG8_WAIT_L(0); PG8_MMA(0, 0, At, B0); PG8_BAR; PG8_SCHED;
            PG8_LDB(B1, 1, 1); PG8_STAGE(PG8_SB(1, 0), b3, voffB);
            PG8_BAR; PG8_WAIT_L(0); PG8_MMA(0, 1, At, B1); PG8_BAR;
            PG8_LDA(At, 1, 1); PG8_STAGE(PG8_SA(1, 0), a3, voffA);
            PG8_BAR; PG8_WAIT_L(0); PG8_MMA(1, 0, At, B0); PG8_BAR; PG8_SCHED;
            PG8_STAGE(PG8_SB(1, 1), b3 + hstep, voffB);
            PG8_WAIT_V(6); PG8_BAR; PG8_MMA(1, 1, At, B1); PG8_BAR;
            }
        }
        if constexpr (ALIGN_EPI) { if (wr == 0) PG8_BAR; }
        if constexpr (!Epi::AFTER_DRAIN) { E(acc, cur, wr, wc, fr, fq); S.done(cur); }
        if (!has_next) break;
#pragma unroll
        for (int a = 0; a < 2; ++a)
#pragma unroll
            for (int b = 0; b < 2; ++b)
#pragma unroll
                for (int m = 0; m < 4; ++m)
#pragma unroll
                    for (int n = 0; n < 2; ++n) acc[a][b][m][n] = (f32x4){0.f, 0.f, 0.f, 0.f};
        cur = nxt; cA = nA; cB = nB; ++ui;
        if constexpr (ALIGN_EPI) { if (wr == 1) PG8_BAR; }
    }
    PG8_WAIT_V(0);
    if constexpr (!ALIGN_EPI) { if (wr == 0) PG8_BAR; }
    PG8_BAR;
    if constexpr (Epi::AFTER_DRAIN) { E.fused(acc, cur, wr, wc, fr, fq, lds, wid, lane); S.done(cur); }
#undef PG8_SA
#undef PG8_SB
#undef PG8_STAGE
#undef PG8_LDA
#undef PG8_LDB
#undef PG8_HALF
#undef PG8_MMA
#undef PG8_UNI
#undef PG8_WAIT_V
#undef PG8_WAIT_L
#undef PG8_BAR
#undef PG8_SCHED
}
}
#include <hip/hip_bf16.h>
namespace attn_body {
using bf16=__hip_bfloat16;
using bf16x8=__attribute__((ext_vector_type(8)))short;
using s16x4=__attribute__((ext_vector_type(4)))short;
using f32x16=__attribute__((ext_vector_type(16)))float;
using u32x4=__attribute__((ext_vector_type(4)))unsigned;
constexpr int BATCH=4,NHEAD=8,SEQ=8192,D=64,DMQ=1024,DMK=512;
constexpr int NW=8,QBLK=32,QB=QBLK*NW,KVBLK=64,NQB=SEQ/QB;
constexpr int ATTN_UNIT_ROWS=QB;
__device__ __forceinline__ int crow(int r,int hi){return (r&3)+8*(r>>2)+4*hi;}
#define SBAR() __builtin_amdgcn_sched_barrier(0)
__device__ __forceinline__ void cmask(f32x16&p0,f32x16&p1,int jb,int qrel,int hi){
  const float NEG=-INFINITY; int lim=qrel-(64*jb+4*hi); asm volatile("":"+v"(lim));
  #pragma unroll
  for(int r=0;r<16;++r){const int c=(r&3)+8*(r>>2); if(c>lim)p0[r]=NEG; if(c+32>lim)p1[r]=NEG;}
}

constexpr int NSLOT=3, SLOTB=8192;
constexpr int LDS_K=0, LDS_V=NSLOT*SLOTB, LDS_WS=2*NSLOT*SLOTB, LDS_OST=LDS_WS+NW*64*4, LDS_BYTES=LDS_OST+NW*4096, LDS_FSB=LDS_BYTES, LDS_TOTAL=LDS_FSB+SEQ*4;
constexpr float C2=0.125f*1.4426950408889634f;
__device__ __forceinline__ void glds16(const void*gsrc,unsigned lds_dst){unsigned keep;
  asm volatile("s_mov_b32 %0, m0\n\ts_mov_b32 m0, %2\n\ts_nop 0\n\tglobal_load_lds_dwordx4 %1, off\n\ts_mov_b32 m0, %0":"=&s"(keep):"v"(gsrc),"s"(lds_dst):"memory");}
__device__ __forceinline__ float max3f(float a,float b,float c){float r;asm("v_max3_f32 %0, %1, %2, %3":"=v"(r):"v"(a),"v"(b),"v"(c));return r;}
__device__ __forceinline__ float max2f(float a,float b){float r;asm("v_max_f32_e32 %0, %1, %2":"=v"(r):"v"(a),"v"(b));return r;}
__device__ __forceinline__ float fadd_s(float a,float b){float r;asm("v_add_f32_e32 %0, %1, %2":"=v"(r):"v"(a),"v"(b));return r;}
__device__ __forceinline__ float fsub_s(float a,float b){float r;asm("v_sub_f32_e32 %0, %1, %2":"=v"(r):"v"(a),"v"(b));return r;}
typedef float f32x2_t __attribute__((ext_vector_type(2))); typedef __bf16 bf16x2_t __attribute__((ext_vector_type(2)));
__device__ __forceinline__ unsigned cvtpk_s(float lo,float hi){f32x2_t v={lo,hi};bf16x2_t b=__builtin_convertvector(v,bf16x2_t);return __builtin_bit_cast(unsigned,b);}
#define WAIT_BAR(N) asm volatile("s_waitcnt vmcnt(" #N ") lgkmcnt(0)\n\ts_barrier":::"memory")

__device__ __forceinline__ void qkt(f32x16&p0,f32x16&p1,const char*Kslot,const bf16x8*qr,int r32,int hi){
  const char*kb=Kslot+hi*1024+r32*16;
  #pragma unroll
  for(int d0=0;d0<4;++d0){
    const bf16x8 b0=*reinterpret_cast<const bf16x8*>(kb+d0*2048);
    const bf16x8 b1=*reinterpret_cast<const bf16x8*>(kb+d0*2048+512);
    p0=__builtin_amdgcn_mfma_f32_32x32x16_bf16(b0,qr[d0],p0,0,0,0);p1=__builtin_amdgcn_mfma_f32_32x32x16_bf16(b1,qr[d0],p1,0,0,0);}
}
typedef __attribute__((address_space(3))) const char* lds_cptr;
typedef short v4i16_t __attribute__((ext_vector_type(4)));
__device__ __forceinline__ void kload8(bf16x8*kf,lds_cptr kp){
  kf[0]=*(const __attribute__((address_space(3))) bf16x8*)(kp);      kf[1]=*(const __attribute__((address_space(3))) bf16x8*)(kp+512);
  kf[2]=*(const __attribute__((address_space(3))) bf16x8*)(kp+2048); kf[3]=*(const __attribute__((address_space(3))) bf16x8*)(kp+2560);
  kf[4]=*(const __attribute__((address_space(3))) bf16x8*)(kp+4096); kf[5]=*(const __attribute__((address_space(3))) bf16x8*)(kp+4608);
  kf[6]=*(const __attribute__((address_space(3))) bf16x8*)(kp+6144); kf[7]=*(const __attribute__((address_space(3))) bf16x8*)(kp+6656);
}
__device__ __forceinline__ void kload2(bf16x8*kf,lds_cptr kp,int j){ kf[2*j]=*(const __attribute__((address_space(3))) bf16x8*)(kp+j*2048); kf[2*j+1]=*(const __attribute__((address_space(3))) bf16x8*)(kp+j*2048+512); }
__device__ __forceinline__ s16x4 vtr(lds_cptr p){ return __builtin_bit_cast(s16x4,__builtin_amdgcn_ds_read_tr16_b64_v4i16((__attribute__((address_space(3))) v4i16_t*)p)); }
__device__ __forceinline__ float rowmax(const f32x16&p0,const f32x16&p1){
  float a=max3f(p0[0],p0[1],p1[0]),b=max3f(p0[2],p0[3],p1[1]);a=max3f(a,p1[2],p1[3]);
  #pragma unroll
  for(int r=4;r<16;r+=4){a=max3f(a,p0[r],p0[r+1]);b=max3f(b,p0[r+2],p0[r+3]);a=max3f(a,p1[r],p1[r+1]);b=max3f(b,p1[r+2],p1[r+3]);}
  const float m=max2f(a,b);
  auto rr=__builtin_amdgcn_permlane32_swap(__float_as_uint(m),__float_as_uint(m),false,false);
  return max2f(__uint_as_float(rr[0]),__uint_as_float(rr[1]));
}
__device__ __forceinline__ void pv(f32x16*o,int vb,bf16x8 pa0,bf16x8 pa1,bf16x8 pa2,bf16x8 pa3){
  #pragma unroll
  for(int d0=0;d0<2;++d0){s16x4 lo[4],hi[4];
    #pragma unroll
    for(int ks=0;ks<4;++ks){
      asm volatile("ds_read_b64_tr_b16 %0,%1 offset:%c2":"=&v"(lo[ks]):"v"(vb),"i"(d0*4096+ks*1024):"memory");
      asm volatile("ds_read_b64_tr_b16 %0,%1 offset:%c2":"=&v"(hi[ks]):"v"(vb),"i"(d0*4096+ks*1024+512):"memory");}
    asm volatile("s_waitcnt lgkmcnt(0)":::"memory");SBAR();
    #define PK(k) (bf16x8){lo[k][0],lo[k][1],lo[k][2],lo[k][3],hi[k][0],hi[k][1],hi[k][2],hi[k][3]}
    o[d0]=__builtin_amdgcn_mfma_f32_32x32x16_bf16(pa0,PK(0),o[d0],0,0,0);
    o[d0]=__builtin_amdgcn_mfma_f32_32x32x16_bf16(pa1,PK(1),o[d0],0,0,0);
    o[d0]=__builtin_amdgcn_mfma_f32_32x32x16_bf16(pa2,PK(2),o[d0],0,0,0);
    o[d0]=__builtin_amdgcn_mfma_f32_32x32x16_bf16(pa3,PK(3),o[d0],0,0,0);
    #undef PK
  }
}

#ifndef ATTN_STORE16
#define ATTN_STORE16(p,v) (*(u32x4*)(p)=(v))
#endif
template<int THRL,bool FAST> __device__ __forceinline__ void attn_unit(int b,int h,int qb,const bf16*Q,const bf16*__restrict__ K,const bf16*__restrict__ V,bf16*O,const float*__restrict__ Fp,const int*__restrict__ j0tab,float qmaxv,char*shm){
  const int tid=threadIdx.x,lane=tid&63,r32=lane&31,hi=lane>>5; const int wid=__builtin_amdgcn_readfirstlane(tid>>6);
  const long rowbase=(long)b*SEQ; const int q0=qb*QB;
  const bf16*Qw=Q+(rowbase+q0+wid*QBLK)*DMQ+h*D;
  const bf16*Kh=K+rowbase*DMK+h*D,*Vh=V+rowbase*DMK+h*D;
  const unsigned lds0=(unsigned)(uintptr_t)shm;
  float*wsf=(float*)(shm+LDS_WS)+wid*64;
  const bf16*ksrc=Kh+(long)lane*DMK+wid*8;
  const bf16*vsrc=Vh+(long)(16*(wid&3)+(lane>>2))*DMK+(wid>>2)*32+(lane&3)*8;
  const unsigned kdst=lds0+LDS_K+wid*1024, vdst=lds0+LDS_V+wid*1024;
  #define DMA_K(t,slot) glds16(ksrc+(long)(t)*KVBLK*DMK,(unsigned)__builtin_amdgcn_readfirstlane(kdst+(slot)))
  #define DMA_V(t,slot) glds16(vsrc+(long)(t)*KVBLK*DMK,(unsigned)__builtin_amdgcn_readfirstlane(vdst+(slot)))
  const int vb0=(int)(lds0+LDS_V)+((lane>>4)&1)*32+(lane&3)*8+(4*hi+((lane&15)>>2))*64;
  const char*Kbase=shm+LDS_K; bf16x8 kf[8];
  const lds_cptr shm3=(lds_cptr)shm; const lds_cptr kp0=shm3+LDS_K+hi*1024+r32*16; const lds_cptr vp0=shm3+LDS_V+((lane>>4)&1)*32+(lane&3)*8+(4*hi+((lane&15)>>2))*64;
  const int j0=__builtin_amdgcn_readfirstlane(j0tab[(b*NHEAD+h)*NQB+qb]);
  { const float*Fh=Fp+(long)(b*NHEAD+h)*SEQ; const float fref=Fh[q0]; __attribute__((address_space(3))) float*fw=(__attribute__((address_space(3))) float*)((lds_cptr)shm+LDS_FSB);
    const float usub=FAST?qmaxv+(fref-Fh[q0+QB-1])*1.4426950408889634f:0.f;
    for(int s=j0*KVBLK+tid;s<q0+QB;s+=NW*64)fw[s]=(fref-Fh[s])*1.4426950408889634f-usub; }
  asm volatile("s_waitcnt vmcnt(0) lgkmcnt(0)":::"memory");
  const int NT=(q0+QB)/KVBLK-j0;
  ksrc+=(long)j0*KVBLK*DMK; vsrc+=(long)j0*KVBLK*DMK;
  const __attribute__((address_space(3))) float*fsb=(const __attribute__((address_space(3))) float*)((lds_cptr)shm+LDS_FSB)+4*hi+j0*KVBLK;
  DMA_K(0,0);DMA_V(0,0);DMA_K(1,SLOTB);
  bf16x8 qr[4];
  #pragma unroll
  for(int d0=0;d0<4;++d0)qr[d0]=*reinterpret_cast<const bf16x8*>(&Qw[(long)r32*DMQ+d0*16+hi*8]);
  float mhat=0.f,l_reg=0.f;f32x16 o[2];o[0]=f32x16{};o[1]=f32x16{};
  const int qrel=wid*QBLK+r32;
  #define CMASK(P0,P1,t) do{int jb_=(t)-(NT-4); if(jb_>=0)cmask(P0,P1,jb_,qrel,hi);}while(0)
  bool resc=false;
  typedef float f32x4b __attribute__((ext_vector_type(4)));
  #define BIASC(C0,C1,t) do{ const __attribute__((address_space(3))) float*fb_=fsb+(t)*KVBLK; \
    _Pragma("unroll") for(int g_=0;g_<4;++g_){ const f32x4b x_=*(const __attribute__((address_space(3))) f32x4b*)(fb_+8*g_); const f32x4b y_=*(const __attribute__((address_space(3))) f32x4b*)(fb_+32+8*g_); \
      _Pragma("unroll") for(int i_=0;i_<4;++i_){ C0[4*g_+i_]=FAST?x_[i_]:x_[i_]-mhat; C1[4*g_+i_]=FAST?y_[i_]:y_[i_]-mhat; } } }while(0)
  #define START(P0,P1) do{ const float rm=rowmax(P0,P1); resc=false; \
    { const float dl=rm; mhat=fadd_s(mhat,dl); \
      _Pragma("unroll") for(int r=0;r<16;++r){P0[r]=fsub_s(P0[r],dl);P1[r]=fsub_s(P1[r],dl);} } \
    _Pragma("unroll") for(int r=0;r<16;++r)P0[r]=__builtin_amdgcn_exp2f(P0[r]); }while(0)
  #define RESC() do{ if(resc){ asm volatile("s_waitcnt lgkmcnt(0)":::"memory"); \
      _Pragma("unroll") for(int d_=0;d_<2;++d_) _Pragma("unroll") for(int r=0;r<16;++r)o[d_][r]*=wsf[crow(r,hi)]; } }while(0)
  f32x16 pA0,pA1,pB0,pB1;
  int sl_prev=0,sl_cur=0,sl_next=SLOTB;
  #define ROT() do{sl_prev=sl_cur;sl_cur=sl_next;sl_next=(sl_next==(NSLOT-1)*SLOTB)?0:sl_next+SLOTB;}while(0)
  DMA_K(2,2*SLOTB);
  WAIT_BAR(3);
  if(!FAST)mhat=qmaxv+((const __attribute__((address_space(3))) float*)((lds_cptr)shm+LDS_FSB))[q0+qrel];
  BIASC(pA0,pA1,0); qkt(pA0,pA1,Kbase,qr,r32,hi);asm volatile("s_nop 15\n\ts_nop 7":"+v"(pA0),"+v"(pA1));
  CMASK(pA0,pA1,0); resc=false;
  _Pragma("unroll") for(int r=0;r<16;++r)pA0[r]=__builtin_amdgcn_exp2f(pA0[r]);
  _Pragma("unroll") for(int r=0;r<16;++r)pA1[r]=__builtin_amdgcn_exp2f(pA1[r]);
  WAIT_BAR(0);
  DMA_K(3,0);DMA_V(1,SLOTB);
  ROT();
  kload8(kf,kp0+sl_cur);
  WAIT_BAR(2);
  s16x4 vlo[8],vhi[8]; u32x4 pw0,pw1,pw2,pw3;
  #define PKW(P,B) cvtpk_s(P[B],P[B+1])
  #define PAF(k) __builtin_bit_cast(bf16x8,pw##k)
  #define VFR(i) (bf16x8){vlo[i][0],vlo[i][1],vlo[i][2],vlo[i][3],vhi[i][0],vhi[i][1],vhi[i][2],vhi[i][3]}
  #define PIN(x) asm volatile("":"+v"(x))
  #define MX3(a,b,c) __builtin_fmaxf(__builtin_fmaxf((a),(b)),(c))
  #define GAPA(MF,A0,A1,A2,A3,W0,W1,PW) do{ MF; sacc+=A0; sacc+=A1; sacc+=A2; sacc+=A3; PIN(sacc); W0; W1; PIN(PW); SBAR(); }while(0)
  #define EX(v) __builtin_amdgcn_exp2f(v)
  #define GAPB(MF,X,B) do{ MF; X[B]=EX(X[B]); X[B+1]=EX(X[B+1]); X[B+2]=EX(X[B+2]); X[B+3]=EX(X[B+3]); PIN(X); SBAR(); }while(0)
  #define VRD(i) do{ vlo[i]=vtr(vp_+(((i)>>2)*4096+((i)&3)*1024)); vhi[i]=vtr(vp_+(((i)>>2)*4096+((i)&3)*1024+512)); }while(0)
  #define KRD(G,j) do{ if(G){ kload2(kf,kp0+sl_next,j); SBAR(); } }while(0)
  #define STEP(C0,C1,P0,P1,t,GK,GV,GL) do{ SBAR(); \
    BIASC(C0,C1,t); SBAR(); \
    const lds_cptr vp_=vp0+sl_prev; \
    VRD(0); SBAR(); float sacc=(P0[0]+P0[1]); \
    GAPA(C0=__builtin_amdgcn_mfma_f32_32x32x16_bf16(kf[0],qr[0],C0,0,0,0), P0[2],P0[3],P0[4],P0[5],     pw0[0]=PKW(P0,0), pw0[1]=PKW(P0,2), pw0); \
    VRD(4); SBAR(); GAPA(C1=__builtin_amdgcn_mfma_f32_32x32x16_bf16(kf[1],qr[0],C1,0,0,0), P0[6],P0[7],P0[8],P0[9],     pw0[2]=PKW(P0,4), pw0[3]=PKW(P0,6), pw0); \
    VRD(1); SBAR(); GAPA(C0=__builtin_amdgcn_mfma_f32_32x32x16_bf16(kf[2],qr[1],C0,0,0,0),   P0[10],P0[11],P0[12],P0[13], pw1[0]=PKW(P0,8), pw1[1]=PKW(P0,10), pw1); \
    VRD(5); SBAR(); GAPA(C1=__builtin_amdgcn_mfma_f32_32x32x16_bf16(kf[3],qr[1],C1,0,0,0),   P0[14],P0[15],P1[0],P1[1],   pw1[2]=PKW(P0,12),pw1[3]=PKW(P0,14), pw1); \
    VRD(2); SBAR(); GAPA(C0=__builtin_amdgcn_mfma_f32_32x32x16_bf16(kf[4],qr[2],C0,0,0,0),   P1[2],P1[3],P1[4],P1[5],     pw2[0]=PKW(P1,0), pw2[1]=PKW(P1,2), pw2); \
    VRD(6); SBAR(); GAPA(C1=__builtin_amdgcn_mfma_f32_32x32x16_bf16(kf[5],qr[2],C1,0,0,0),   P1[6],P1[7],P1[8],P1[9],     pw2[2]=PKW(P1,4), pw2[3]=PKW(P1,6), pw2); \
    VRD(3); SBAR(); GAPA(C0=__builtin_amdgcn_mfma_f32_32x32x16_bf16(kf[6],qr[3],C0,0,0,0),   P1[10],P1[11],P1[12],P1[13], pw3[0]=PKW(P1,8), pw3[1]=PKW(P1,10), pw3); \
    VRD(7); SBAR(); GAPA(C1=__builtin_amdgcn_mfma_f32_32x32x16_bf16(kf[7],qr[3],C1,0,0,0),   P1[14],P1[15],0.f,0.f,       pw3[2]=PKW(P1,12),pw3[3]=PKW(P1,14), pw3); \
    l_reg+=sacc; \
    if(GK){DMA_K((t)+3,sl_cur);} if(GV){DMA_V((t)+1,sl_next);} \
    CMASK(C0,C1,t); \
    SBAR(); \
    GAPB(o[0]=__builtin_amdgcn_mfma_f32_32x32x16_bf16(PAF(0),VFR(0),o[0],0,0,0), C0,0); \
    GAPB(o[1]=__builtin_amdgcn_mfma_f32_32x32x16_bf16(PAF(0),VFR(4),o[1],0,0,0), C0,4); \
    KRD(GL,0); GAPB(o[0]=__builtin_amdgcn_mfma_f32_32x32x16_bf16(PAF(1),VFR(1),o[0],0,0,0), C0,8); \
    KRD(GL,1); GAPB(o[1]=__builtin_amdgcn_mfma_f32_32x32x16_bf16(PAF(1),VFR(5),o[1],0,0,0), C0,12); \
    KRD(GL,2); GAPB(o[0]=__builtin_amdgcn_mfma_f32_32x32x16_bf16(PAF(2),VFR(2),o[0],0,0,0), C1,0); \
    KRD(GL,3); GAPB(o[1]=__builtin_amdgcn_mfma_f32_32x32x16_bf16(PAF(2),VFR(6),o[1],0,0,0), C1,4); \
    GAPB(o[0]=__builtin_amdgcn_mfma_f32_32x32x16_bf16(PAF(3),VFR(3),o[0],0,0,0), C1,8); \
    GAPB(o[1]=__builtin_amdgcn_mfma_f32_32x32x16_bf16(PAF(3),VFR(7),o[1],0,0,0), C1,12); \
    }while(0)
  int t=1;
  #undef CMASK
  #define CMASK(P0,P1,t) do{}while(0)
  for(;t+5<NT;t+=2){
    STEP(pB0,pB1,pA0,pA1,t,true,true,true);     WAIT_BAR(2); RESC(); ROT();
    STEP(pA0,pA1,pB0,pB1,t+1,true,true,true);   WAIT_BAR(2); RESC(); ROT();
  }
  #undef CMASK
  #define CMASK(P0,P1,t) do{int jb_=(t)-(NT-4); if(jb_>=0)cmask(P0,P1,jb_,qrel,hi);}while(0)
  #define ENDW(tt) do{ if((tt)+3<NT){WAIT_BAR(2);} else if((tt)+2<NT){WAIT_BAR(1);} else {WAIT_BAR(0);} }while(0)
  for(;t+1<NT;t+=2){
    STEP(pB0,pB1,pA0,pA1,t,(t+3<NT),(t+1<NT),(t+1<NT));       ENDW(t);   RESC(); ROT();
    STEP(pA0,pA1,pB0,pB1,t+1,(t+4<NT),(t+2<NT),(t+2<NT));     ENDW(t+1); RESC(); ROT();
  }
  STEP(pB0,pB1,pA0,pA1,NT-1,false,false,false); RESC();
  { float sacc=pB0[0]+pB0[1]; _Pragma("unroll") for(int r=2;r<16;++r)sacc+=pB0[r]; _Pragma("unroll") for(int r=0;r<16;++r)sacc+=pB1[r]; l_reg+=sacc;
    pw0=(u32x4){PKW(pB0,0),PKW(pB0,2),PKW(pB0,4),PKW(pB0,6)};pw1=(u32x4){PKW(pB0,8),PKW(pB0,10),PKW(pB0,12),PKW(pB0,14)};pw2=(u32x4){PKW(pB1,0),PKW(pB1,2),PKW(pB1,4),PKW(pB1,6)};pw3=(u32x4){PKW(pB1,8),PKW(pB1,10),PKW(pB1,12),PKW(pB1,14)};
    SBAR(); pv(o,vb0+sl_cur,PAF(0),PAF(1),PAF(2),PAF(3)); }
  #undef PKW
  #undef PAF
  #undef VFR
  #undef PIN
  #undef MX3
  #undef GAPA
  #undef GAPB
  #undef EX
  #undef VRD
  #undef KRD
  #undef STEP
  #undef ENDW
  {auto rr=__builtin_amdgcn_permlane32_swap(__float_as_uint(l_reg),__float_as_uint(l_reg),false,false);l_reg=__uint_as_float(rr[0])+__uint_as_float(rr[1]);}
  if(hi==0)wsf[32+r32]=l_reg;asm volatile("s_waitcnt lgkmcnt(0)":::"memory");
  float rli[16];
  #pragma unroll
  for(int r=0;r<16;++r)rli[r]=__builtin_amdgcn_rcpf(wsf[32+crow(r,hi)]);
  bf16*Ow=O+(rowbase+q0+wid*QBLK)*DMQ+h*D;
  { bf16*stg=(bf16*)(shm+LDS_OST)+wid*2048;
    #pragma unroll
    for(int r=0;r<16;++r){const int orow=crow(r,hi);
      #pragma unroll
      for(int d0=0;d0<2;++d0)stg[orow*64+d0*32+r32]=__float2bfloat16(o[d0][r]*rli[r]);}
    asm volatile("s_waitcnt lgkmcnt(0)":::"memory");
    #pragma unroll
    for(int i=0;i<4;++i){const int row=i*8+(lane>>3),ch=lane&7; const u32x4 v=*(const u32x4*)(stg+row*64+ch*8); ATTN_STORE16(Ow+(long)row*DMQ+ch*8,v);} }
  asm volatile("s_waitcnt lgkmcnt(0)\n\ts_barrier":::"memory");
  #undef DMA_K
  #undef DMA_V
  #undef CMASK
  #undef START
  #undef BIASC
  #undef RESC
  #undef ROT
}
constexpr int ATTN_LDS_BYTES=LDS_TOTAL;
struct AttnTensors { const bf16* Q; const bf16* K; const bf16* V; bf16* O; const float* Fp; const int* j0tab; float qmax; };
struct AttnUnit { int bh; int qb; };
struct StaticOrder {
  int vcu;
  __device__ __forceinline__ explicit StaticOrder(int grid,int block):vcu((block%8)*(grid/8)+block/8){}
  __device__ __forceinline__ bool next(int i,AttnUnit&u)const{ if(i>=4)return false; const int s=vcu&7; u.bh=vcu>>3; u.qb=(i==0)?s:(i==1)?15-s:(i==2)?16+s:31-s; return true; }
  __device__ __forceinline__ void a_ready(const AttnUnit&)const{}
  __device__ __forceinline__ void done(const AttnUnit&)const{}
};
template<class Sched,int THRL=8> __device__ __forceinline__ void attn_phase(char*lds,const AttnTensors&T,const Sched&S){
  AttnUnit u;
  for(int i=0;S.next(i,u);++i){ S.a_ready(u);
    const float*Fh=T.Fp+(long)u.bh*SEQ; const float dspan=(Fh[u.qb*QB]-Fh[u.qb*QB+QB-1])*1.4426950408889634f;
    if(__builtin_amdgcn_readfirstlane((int)(2.0f*T.qmax+dspan<110.0f))) attn_unit<THRL,true>(u.bh/NHEAD,u.bh%NHEAD,u.qb,T.Q,T.K,T.V,T.O,T.Fp,T.j0tab,T.qmax,lds);
    else attn_unit<THRL,false>(u.bh/NHEAD,u.bh%NHEAD,u.qb,T.Q,T.K,T.V,T.O,T.Fp,T.j0tab,T.qmax,lds);
    S.done(u); }
}
#undef SBAR
#undef WAIT_BAR
}
#define GAS __attribute__((address_space(1)))
#define LAS __attribute__((address_space(3)))
typedef unsigned short bf16;
typedef unsigned v4u __attribute__((ext_vector_type(4)));
typedef float f32x4 __attribute__((ext_vector_type(4)));
typedef short bf16x8 __attribute__((ext_vector_type(8)));
typedef GAS unsigned gu32;
typedef GAS unsigned long long gu64;
#define RLX_AGENT __ATOMIC_RELAXED, __HIP_MEMORY_SCOPE_AGENT
#define LDS_WAIT() asm volatile("s_waitcnt lgkmcnt(0)" ::: "memory")
#define VM_WAIT() asm volatile("s_waitcnt vmcnt(0)" ::: "memory")
__device__ __forceinline__ unsigned long long rt() { return __builtin_amdgcn_s_memrealtime(); }
__device__ __forceinline__ unsigned f2bf(float f) { unsigned u = __builtin_bit_cast(unsigned, f); return (u + 0x7fffu + ((u >> 16) & 1u)) >> 16; }
__device__ __forceinline__ unsigned pk2(float lo, float hi) { return f2bf(lo) | (f2bf(hi) << 16); }

#define XB_TMO      128
#define XB_XCNT(j)  (256  + 64 * (j))
#define XB_XSUB(j)  (1280 + 64 * (j))
#define XB_XGEN(j)  (2304 + 64 * (j))
#define XB_TOP      3328
#define XB_TOPGEN   3392
#define XB_FLAG(j)  (3456 + 64 * (j))
#define XCD_BAR_WORDS 4480
#define XB_SPIN_CAP (1u << 18)

__device__ __forceinline__ unsigned xb_ld(unsigned* p)              { return __hip_atomic_load(p, __ATOMIC_RELAXED, __HIP_MEMORY_SCOPE_AGENT); }
__device__ __forceinline__ unsigned xb_add(unsigned* p, unsigned v) { return __hip_atomic_fetch_add(p, v, __ATOMIC_RELAXED, __HIP_MEMORY_SCOPE_AGENT); }
__device__ __forceinline__ unsigned xb_xcc_id() { return (unsigned)__builtin_amdgcn_s_getreg((3 << 11) | 20) & 0xFu; }
#define XB_SPIN(cond, bar) do { unsigned _sp = 0; while (cond) { __builtin_amdgcn_s_sleep(1); \
    if ((++_sp & 255u) == 0u) { if (xb_ld(&(bar)[XB_TMO])) break; if (_sp > XB_SPIN_CAP) { atomicAdd(&(bar)[XB_TMO], 1u); break; } } } } while (0)

struct XcdBarrier {
    unsigned* bar; unsigned x;
    volatile LAS unsigned* st;
};

__device__ __forceinline__ XcdBarrier xcd_barrier_post(unsigned* bar, volatile LAS unsigned* st) {
    XcdBarrier b; b.bar = bar; b.x = xb_xcc_id(); b.st = st;
    if (threadIdx.x == 0) (void)xb_add(&bar[XB_XCNT(b.x)], 1u);
    return b;
}
__device__ __forceinline__ void xcd_barrier_complete(unsigned* bar, unsigned x, unsigned& nloc, unsigned& nx) {
    const unsigned G = gridDim.x * gridDim.y * gridDim.z;
    unsigned sum, cnt, mine, msk, sp = 0u;
    for (;;) {
        sum = 0u; cnt = 0u; mine = 0u; msk = 0u;
#pragma unroll
        for (unsigned j = 0; j < 16; ++j) { const unsigned c = xb_ld(&bar[XB_XCNT(j)]); sum += c; cnt += (c > 0u) ? 1u : 0u; msk |= (c > 0u) ? (1u << j) : 0u; mine = (j == x) ? c : mine; }
        if (sum == G) break;
        __builtin_amdgcn_s_sleep(1);
        if ((++sp & 255u) == 0u) { if (xb_ld(&bar[XB_TMO])) break; if (sp > XB_SPIN_CAP) { atomicAdd(&bar[XB_TMO], 1u); break; } }
    }
    nloc = mine > 0u ? mine : 1u; nx = msk;
}

__device__ __forceinline__ void xcd_barrier(const XcdBarrier& b) {
    asm volatile("s_waitcnt vmcnt(0)" ::: "memory");
    __syncthreads();
    if (threadIdx.x == 0) {
        unsigned* bar = b.bar;
        __builtin_amdgcn_s_waitcnt(0);
        unsigned nloc = b.st[0], nx = b.st[1];
        if (nloc == 0u) { xcd_barrier_complete(bar, b.x, nloc, nx); b.st[0] = nloc; b.st[1] = nx; }
        const unsigned old = xb_add(&bar[XB_XSUB(b.x)], 1u);
        const unsigned gen = old / nloc;
        if (old + 1u == (gen + 1u) * nloc) {
            __builtin_amdgcn_fence(__ATOMIC_RELEASE, "agent");
            asm volatile("s_waitcnt vmcnt(0)" ::: "memory");
            __hip_atomic_store(&bar[XB_FLAG(b.x)], gen + 1u, __ATOMIC_RELAXED, __HIP_MEMORY_SCOPE_AGENT);
            { unsigned _sp = 0;
              for (;;) { unsigned ok = 1u;
#pragma unroll
                  for (unsigned j = 0; j < 16; ++j) { const unsigned f = xb_ld(&bar[XB_FLAG(j)]); ok &= (((nx >> j) & 1u) == 0u || f > gen) ? 1u : 0u; }
                  if (ok) break;
                  __builtin_amdgcn_s_sleep(1);
                  if ((++_sp & 255u) == 0u) { if (xb_ld(&bar[XB_TMO])) break; if (_sp > XB_SPIN_CAP) { atomicAdd(&bar[XB_TMO], 1u); break; } } } }
            __builtin_amdgcn_fence(__ATOMIC_ACQUIRE, "agent");
            xb_add(&bar[XB_XGEN(b.x)], 1u);
            asm volatile("s_waitcnt vmcnt(0)" ::: "memory");
        } else {
            XB_SPIN(xb_ld(&bar[XB_XGEN(b.x)]) == gen, bar);
            __builtin_amdgcn_fence(__ATOMIC_ACQUIRE, "agent");
            asm volatile("s_waitcnt vmcnt(0)" ::: "memory");
        }
    }
    __syncthreads();
}
constexpr int NWAVES = 8;
#ifndef MK_N_LAUNCHES
#define MK_N_LAUNCHES 1
#endif
constexpr int N_PHASES = 12;
constexpr int N_LAUNCHES = MK_N_LAUNCHES;
static_assert(N_LAUNCHES == 1 || N_LAUNCHES == N_PHASES, "MK_N_LAUNCHES is 1 or 12");

constexpr int D = 1024, FF = 2816, NUP = 2 * FF, DATT = 512, NH = 8, HD = 64, DCONV = 512, CW = 31, CS = 30;
constexpr int TP = 8192, NBP = 4, MP = NBP * TP, NBS = 16, TS = 16, MS = NBS * TS, M = MP + MS, PAST = 2048;
constexpr int NIN = 2560, DIN = 2568, NMOD = 9, MODW = NMOD * D, NB = NBP + NBS;
constexpr float EPS = 1e-6f, LOG2E = 1.4426950408889634f;
static_assert(MODW == pg8::EP_MODW && M % 256 == 0, "shapes");
constexpr size_t O_YP = 0, O_YS = O_YP + (size_t)MP * D, O_KP = O_YS + (size_t)MS * D, O_VP = O_KP + (size_t)MP * DATT, O_LP = O_VP + (size_t)MP * DATT,
    O_CP = O_LP + (size_t)MP * NH, O_KS = O_CP + (size_t)NBP * CS * DCONV, O_VS = O_KS + (size_t)MS * DATT, O_LS = O_VS + (size_t)MS * DATT, O_CS = O_LS + (size_t)MS * NH,
    O_END = O_CS + (size_t)NBS * CS * DCONV;
static_assert(O_END == 68204544, "output size");
enum { I_XP = 0, I_XS, I_CP, I_CSM, I_CK, I_CV, I_CLF, I_SCONV, I_WADA, I_BADA, I_GFFN1, I_WUP1, I_WDN1, I_GMIX, I_WIN, I_BF, I_GQ, I_GK, I_CONVW, I_CONVB, I_LNG, I_LNB, I_WOUT, I_GFFN2, I_WUP2, I_WDN2, I_GFIN, N_IN };
static_assert(N_IN == 27, "inputs");

constexpr size_t MiB = 1u << 20;
constexpr size_t WS_CTL = 0, CTL_ZERO_BYTES = 64 * 1024;
constexpr size_t WS_MODP = 1 * MiB;
constexpr size_t WS_MOD = 4 * MiB;
constexpr size_t WS_J0 = 7 * MiB;
constexpr size_t WS_FP = 5 * MiB;
constexpr size_t WS_WUP1 = 8 * MiB, WS_WDN1 = 19 * MiB, WS_WIN = 25 * MiB, WS_WOUT = 30 * MiB, WS_WUP2 = 32 * MiB, WS_WDN2 = 43 * MiB;
constexpr size_t WS_HN = 50 * MiB;
constexpr size_t WS_X = 116 * MiB;
constexpr size_t WS_HID = 246 * MiB;
constexpr size_t WS_A2 = 246 * MiB, WS_KB = 311 * MiB, WS_VB = 344 * MiB, WS_UB = 377 * MiB;
constexpr size_t WS_PART = 424 * MiB;
constexpr size_t WS_SPRIV = 436 * MiB;
constexpr size_t WS_XSB = 442 * MiB;
constexpr size_t WS_XSA = 443 * MiB;
constexpr size_t WS_END = 444 * MiB;
static_assert(WS_MODP + 4ull * NB * MODW * 4 <= WS_MOD && WS_MOD + (size_t)NB * MODW * 4 <= WS_FP && WS_FP + (size_t)NBP * NH * TP * 4 <= WS_WUP1, "ws map 1");
static_assert(WS_WUP1 + (size_t)NUP * D * 2 <= WS_WDN1 && WS_WDN1 + (size_t)D * FF * 2 <= WS_WIN && WS_WIN + (size_t)NIN * D * 2 <= WS_WOUT && WS_WOUT + (size_t)D * D * 2 <= WS_WUP2 && WS_WUP2 + (size_t)NUP * D * 2 <= WS_WDN2 && WS_WDN2 + (size_t)D * FF * 2 <= WS_HN, "ws map 2");
static_assert(WS_HN + (size_t)M * D * 2 <= WS_X && WS_X + (size_t)M * D * 4 <= WS_HID && WS_HID + (size_t)M * FF * 2 <= WS_PART && WS_PART + 11ull * 256 * 1024 * 4 <= WS_SPRIV && WS_SPRIV + 22ull * 256 * 1024 <= WS_XSB && WS_SPRIV + 10ull * 256 * 1024 * 2 <= WS_XSB && WS_XSB + 256ull * 1024 * 4 <= WS_XSA && WS_XSA + 256ull * 1024 * 4 <= WS_END, "ws map 3");
static_assert(WS_A2 + (size_t)M * D * 2 <= WS_KB && WS_KB + (size_t)M * DATT * 2 <= WS_VB && WS_VB + (size_t)M * DATT * 2 <= WS_UB && WS_UB + (size_t)M * DCONV * 2 <= WS_PART, "ws map 4");
constexpr int CW_BAR = 4096, CW_AQ = 1024, CW_SUB = 2048;

constexpr int RING_OFF = 0, RING_BYTES = 131072;
constexpr int LDSCTL_OFF = RING_BYTES, MISC_OFF = LDSCTL_OFF + 320;
constexpr int LDS_BYTES = 147456;
static_assert(MISC_OFF + 128 <= LDS_BYTES && attn_body::ATTN_LDS_BYTES <= RING_BYTES, "LDS map");

struct Frame {
    LAS unsigned char* lds;
    volatile LAS unsigned* MISC;
    int wave;
    int vcu, G;
};
__device__ __forceinline__ const float* inp_ptr(int i) { asm volatile("" : "+s"(i)); return ((const float* const __attribute__((address_space(4)))*)__builtin_amdgcn_kernarg_segment_ptr())[i]; }
#define INP(i) inp_ptr(i)
#define OUTP() ((float*)inp_ptr(N_IN))
#define WSP() ((unsigned char*)inp_ptr(N_IN + 1))
__device__ __forceinline__ float wave_sum(float v) { return xsum32(xsum16(row_sum16(v))); }
__device__ __forceinline__ float wave_max(float v) { return xmax32(xmax16(row_max16(v))); }
__device__ __forceinline__ float bf2f(bf16 b) { return __builtin_bit_cast(float, (unsigned)b << 16); }

__device__ __forceinline__ void p0_mod_task(Frame& F, int task) {
    unsigned char* const ws_ = WSP();
    const int cu = task >> 2, kq = task & 3;
    LAS float* sc = (LAS float*)(F.lds);
    LAS float* red = (LAS float*)(F.lds + 20480);
    const float* cpp = INP(I_CP); const float* csp = INP(I_CSM);
    for (int e = ((int)threadIdx.x); e < NB * 256; e += NWAVES * 64) { const int r = e >> 8, j = e & 255; const float c = r < NBP ? cpp[r * D + 256 * kq + j] : csp[(r - NBP) * D + 256 * kq + j]; sc[e] = c / (1.0f + __expf(-c)); }
    __syncthreads();
    f32x4 acc[NB];
#pragma unroll
    for (int r = 0; r < NB; ++r) acc[r] = (f32x4){0.f, 0.f, 0.f, 0.f};
    const float* Wp = INP(I_WADA) + (size_t)(256 * kq + 32 * F.wave) * MODW + 256 * cu + 4 * ((int)(threadIdx.x & 63));
#pragma unroll 1
    for (int i = 0; i < 32; i += 4) {
        f32x4 w[4];
#pragma unroll
        for (int ii = 0; ii < 4; ++ii) w[ii] = __builtin_nontemporal_load((const f32x4*)(Wp + (size_t)(i + ii) * MODW));
#pragma unroll
        for (int r = 0; r < NB; ++r) { const f32x4 s = *(const LAS f32x4*)(sc + r * 256 + 32 * F.wave + i); acc[r] += s[0] * w[0] + s[1] * w[1] + s[2] * w[2] + s[3] * w[3]; }
    }
#pragma unroll
    for (int half = 0; half < 2; ++half) {
#pragma unroll
        for (int r = 0; r < 10; ++r) *(LAS f32x4*)(red + (F.wave * 10 + r) * 256 + 4 * ((int)(threadIdx.x & 63))) = acc[half * 10 + r];
        __syncthreads();
        for (int e = ((int)threadIdx.x); e < 2560; e += NWAVES * 64) { const int r = e >> 8, c = e & 255; float s = 0.f;
#pragma unroll
            for (int w = 0; w < NWAVES; ++w) s += red[(w * 10 + r) * 256 + c];
            ((float*)(ws_ + WS_MODP))[((size_t)kq * NB + half * 10 + r) * MODW + 256 * cu + c] = s; }
        __syncthreads();
    }
}
__device__ __forceinline__ void p0_transpose_item(const float* W, int K, int Nsrc, bf16* WT, int n0, int c0, LAS float* scr, int kb, int lane) {
    const int k0 = 64 * kb;
#pragma unroll 8
    for (int i = 0; i < 32; ++i) { const int kk = 2 * i + (lane >> 5); scr[kk * 33 + (lane & 31)] = W[(size_t)(k0 + kk) * Nsrc + c0 + (lane & 31)]; }
    LDS_WAIT(); asm volatile("" ::: "memory");
    const int c = lane & 7;
#pragma unroll
    for (int j = 0; j < 4; ++j) { const int n = (lane >> 3) + 8 * j; const LAS float* s = scr + (8 * c) * 33 + n;
        v4u o; o.x = pk2(s[0 * 33], s[1 * 33]); o.y = pk2(s[2 * 33], s[3 * 33]); o.z = pk2(s[4 * 33], s[5 * 33]); o.w = pk2(s[6 * 33], s[7 * 33]);
        *(GAS v4u*)(WT + (size_t)(n0 + n) * K + k0 + 8 * c) = o; }
    LDS_WAIT(); asm volatile("" ::: "memory");
}
__device__ __forceinline__ void p0_transpose_item_fp8(const float* W, int K, int Nsrc, unsigned char* WT8, int n0, int c0, LAS float* scr, int kb, int lane) {
    const int k0 = 64 * kb;
#pragma unroll 8
    for (int i = 0; i < 32; ++i) { const int kk = 2 * i + (lane >> 5); scr[kk * 33 + (lane & 31)] = W[(size_t)(k0 + kk) * Nsrc + c0 + (lane & 31)]; }
    LDS_WAIT(); asm volatile("" ::: "memory");
    const int n = lane >> 1, kh = lane & 1; const LAS float* s = scr + (32 * kh) * 33 + n;
    v4u o[2];
#pragma unroll
    for (int q = 0; q < 8; ++q) { int w = 0; w = __builtin_amdgcn_cvt_pk_fp8_f32(64.0f * s[(4 * q) * 33], 64.0f * s[(4 * q + 1) * 33], w, false); w = __builtin_amdgcn_cvt_pk_fp8_f32(64.0f * s[(4 * q + 2) * 33], 64.0f * s[(4 * q + 3) * 33], w, true); o[q >> 2][q & 3] = (unsigned)w; }
    GAS v4u* d = (GAS v4u*)(WT8 + (size_t)(n0 + n) * K + k0 + 32 * kh); d[0] = o[0]; d[1] = o[1];
    LDS_WAIT(); asm volatile("" ::: "memory");
}
__device__ __forceinline__ int up_src_col(int n0) { const int pn = n0 >> 8, loc = n0 & 255; return loc < 128 ? 128 * pn + loc : FF + 128 * pn + (loc - 128); }
__device__ __forceinline__ int in_src_col(int n0) { const int pn = n0 >> 8, loc = n0 & 255;
    if (pn < 6) { const int sec = pn >> 1, bj = loc >> 7, wc = (loc & 127) >> 5, head = 4 * (pn & 1) + wc; return sec * DATT + head * HD + 32 * bj; }
    return loc < 128 ? (3 * DATT + NH) + 128 * (pn - 6) + loc : (3 * DATT + NH + DCONV) + 128 * (pn - 6) + (loc - 128); }
__device__ __forceinline__ void p0_prologue(Frame& F) {
    unsigned char* const ws_ = WSP(); float* const out_ = OUTP();
    if ((int)blockIdx.x < 144) { for (int task = blockIdx.x; task < 144; task += F.G) p0_mod_task(F, task); }
    __syncthreads();
    LAS float* scr = (LAS float*)(F.lds + RING_OFF + F.wave * 16384);
    const int gw = F.vcu * NWAVES + F.wave, NGW = F.G * NWAVES;
    constexpr int I_UP = (D / 64) * (NUP / 32), I_DN = (FF / 64) * (D / 32), I_IN = (D / 64) * (NIN / 32), I_OUT = (D / 64) * (D / 32);
    constexpr int NITEMS = 2 * I_UP + 2 * I_DN + I_IN + I_OUT;
    for (int it = gw; it < NITEMS; it += NGW) {
        int r = it;
        if (r < I_UP) { const int nb = r % (NUP / 32), kb = r / (NUP / 32); p0_transpose_item_fp8(INP(I_WUP1), D, NUP, ws_ + WS_WUP1, 32 * nb, up_src_col(32 * nb), scr, kb, ((int)(threadIdx.x & 63))); continue; } r -= I_UP;
        if (r < I_UP) { const int nb = r % (NUP / 32), kb = r / (NUP / 32); p0_transpose_item_fp8(INP(I_WUP2), D, NUP, ws_ + WS_WUP2, 32 * nb, up_src_col(32 * nb), scr, kb, ((int)(threadIdx.x & 63))); continue; } r -= I_UP;
        if (r < I_DN) { const int nb = r % (D / 32), kb = r / (D / 32); p0_transpose_item_fp8(INP(I_WDN1), FF, D, ws_ + WS_WDN1, 32 * nb, 32 * nb, scr, kb, ((int)(threadIdx.x & 63))); continue; } r -= I_DN;
        if (r < I_DN) { const int nb = r % (D / 32), kb = r / (D / 32); p0_transpose_item_fp8(INP(I_WDN2), FF, D, ws_ + WS_WDN2, 32 * nb, 32 * nb, scr, kb, ((int)(threadIdx.x & 63))); continue; } r -= I_DN;
        if (r < I_IN) { const int nb = r % (NIN / 32), kb = r / (NIN / 32); p0_transpose_item(INP(I_WIN), D, DIN, (bf16*)(ws_ + WS_WIN), 32 * nb, in_src_col(32 * nb), scr, kb, ((int)(threadIdx.x & 63))); continue; } r -= I_IN;
        { const int nb = r % (D / 32), kb = r / (D / 32); p0_transpose_item(INP(I_WOUT), D, D, (bf16*)(ws_ + WS_WOUT), 32 * nb, 32 * nb, scr, kb, ((int)(threadIdx.x & 63))); }
    }
    const float* scp = INP(I_SCONV);
    for (int e = (int)blockIdx.x * NWAVES * 64 + ((int)threadIdx.x); e < NBS * 14 * DCONV; e += F.G * NWAVES * 64) { const int b = e / (14 * DCONV), rem = e % (14 * DCONV);
        out_[O_CS + (size_t)b * CS * DCONV + rem] = scp[(size_t)b * CS * DCONV + 16 * DCONV + rem]; }
}

__device__ __forceinline__ f32x4 nr_bf4(const unsigned* p) { const unsigned a = p[0], b = p[1]; f32x4 r; r[0] = __builtin_bit_cast(float, a << 16); r[1] = __builtin_bit_cast(float, a & 0xffff0000u); r[2] = __builtin_bit_cast(float, b << 16); r[3] = __builtin_bit_cast(float, b & 0xffff0000u); return r; }
template <int KIND, bool SRCBF = false> __device__ __forceinline__ void norm_rows(Frame& F, const float* src, bf16* dst, float* dstf, float* dlogf, int nr, int bi, const float* part = nullptr, int npart = 0, float* xw = nullptr) {
    unsigned char* const ws_ = WSP();
    const int lane = ((int)(threadIdx.x & 63));
    f32x4 wv[4], shv[4];
    const float* g = INP(KIND == 1 ? I_GFFN1 : KIND == 2 ? I_GMIX : KIND == 3 ? I_GFFN2 : I_GFIN); const float* bada = INP(I_BADA);
#pragma unroll
    for (int j = 0; j < 4; ++j) { const int k = 4 * lane + 256 * j; const f32x4 gv = *(const f32x4*)(g + k);
        if (KIND == 4) { wv[j] = gv; shv[j] = (f32x4){0.f, 0.f, 0.f, 0.f}; }
        else if (KIND == 1) { const float* mp = (const float*)(ws_ + WS_MODP) + (size_t)bi * MODW + k; f32x4 sh = *(const f32x4*)(bada + k), sc = *(const f32x4*)(bada + D + k);
#pragma unroll
            for (int q = 0; q < 4; ++q) { sh += *(const f32x4*)(mp + (size_t)q * NB * MODW); sc += *(const f32x4*)(mp + (size_t)q * NB * MODW + D); }
            wv[j] = gv * (sc + 1.0f); shv[j] = sh; }
        else { const float* mp = (const float*)(ws_ + WS_MOD) + (size_t)bi * MODW + (KIND == 2 ? 3 : 6) * D + k; const f32x4 sh = *(const f32x4*)mp, sc = *(const f32x4*)(mp + D); wv[j] = gv * (sc + 1.0f); shv[j] = sh; } }
    f32x4 wf[KIND == 2 ? 32 : 1];
    float bfv = 0.f;
    if (KIND == 2) { const float* winp = INP(I_WIN);
#pragma unroll
        for (int j = 0; j < 4; ++j)
#pragma unroll
            for (int i = 0; i < 4; ++i) { const float* wp = winp + (size_t)(4 * lane + 256 * j + i) * DIN + 3 * DATT; wf[2 * (4 * j + i)] = *(const f32x4*)wp; wf[2 * (4 * j + i) + 1] = *(const f32x4*)(wp + 4); }
        bfv = INP(I_BF)[lane & 7];
    }
    constexpr int RPI = KIND == 2 ? 1 : 2;
#define NR_LD(rr, j) (SRCBF ? nr_bf4((const unsigned*)((const bf16*)(const void*)src + (size_t)(rr) * D + 4 * lane + 256 * (j))) : *(const f32x4*)(src + (size_t)(rr) * D + 4 * lane + 256 * (j)))
    f32x4 vn[RPI][4];
#pragma unroll
    for (int q = 0; q < RPI; ++q) {
#pragma unroll
        for (int j = 0; j < 4; ++j) vn[q][j] = NR_LD(q, j); }
#pragma unroll 1
    for (int r = 0; r < nr; r += RPI) {
        f32x4 v[RPI][4];
#pragma unroll
        for (int q = 0; q < RPI; ++q)
#pragma unroll
            for (int j = 0; j < 4; ++j) v[q][j] = vn[q][j];
        if (r + RPI < nr) {
#pragma unroll
            for (int q = 0; q < RPI; ++q) {
#pragma unroll
                for (int j = 0; j < 4; ++j) vn[q][j] = NR_LD(r + RPI + q, j); } }
        if (npart) {
            for (int p = 0; p < npart; ++p) {
#pragma unroll
                for (int q = 0; q < RPI; ++q) { const float* pp = part + (size_t)p * 256 * D + (size_t)(r + q) * D + 4 * lane;
#pragma unroll
                    for (int j = 0; j < 4; ++j) v[q][j] += *(const f32x4*)(pp + 256 * j); } }
            if (xw) {
#pragma unroll
                for (int q = 0; q < RPI; ++q)
#pragma unroll
                    for (int j = 0; j < 4; ++j) *(f32x4*)(xw + (size_t)(r + q) * D + 4 * lane + 256 * j) = v[q][j]; }
        }
        float ss[RPI];
#pragma unroll
        for (int q = 0; q < RPI; ++q) { ss[q] = 0.f;
#pragma unroll
            for (int j = 0; j < 4; ++j) ss[q] += (v[q][j][0] * v[q][j][0] + v[q][j][1] * v[q][j][1]) + (v[q][j][2] * v[q][j][2] + v[q][j][3] * v[q][j][3]); }
#pragma unroll
        for (int q = 0; q < RPI; ++q) ss[q] = wave_sum(ss[q]);
#pragma unroll
        for (int q = 0; q < RPI; ++q) { const float rstd = 1.0f / sqrtf(ss[q] * (1.0f / D) + EPS);
#pragma unroll
            for (int j = 0; j < 4; ++j) v[q][j] = v[q][j] * rstd * wv[j] + shv[j]; }
#pragma unroll
        for (int q = 0; q < RPI; ++q) {
            if (KIND == 4) {
#pragma unroll
                for (int j = 0; j < 4; ++j) __builtin_nontemporal_store(v[q][j], (f32x4*)(dstf + (size_t)(r + q) * D + 4 * lane + 256 * j));
            } else if (KIND == 1 || KIND == 3) {
                GAS unsigned* o4 = (GAS unsigned*)((unsigned char*)dst + (size_t)(r + q) * D) + lane;
#pragma unroll
                for (int j = 0; j < 4; ++j) { int w = 0; w = __builtin_amdgcn_cvt_pk_fp8_f32(v[q][j][0], v[q][j][1], w, false); w = __builtin_amdgcn_cvt_pk_fp8_f32(v[q][j][2], v[q][j][3], w, true); o4[64 * j] = (unsigned)w; }
            } else {
                GAS unsigned long long* o8 = (GAS unsigned long long*)(dst + (size_t)(r + q) * D) + lane;
#pragma unroll
                for (int j = 0; j < 4; ++j) o8[64 * j] = (unsigned long long)pk2(v[q][j][0], v[q][j][1]) | ((unsigned long long)pk2(v[q][j][2], v[q][j][3]) << 32);
            } }
        if (KIND == 2) {
#pragma unroll
            for (int q = 0; q < RPI; ++q) {
                f32x4 f0 = (f32x4){0.f, 0.f, 0.f, 0.f}, f1 = f0;
#pragma unroll
                for (int j = 0; j < 4; ++j)
#pragma unroll
                    for (int i = 0; i < 4; ++i) { f0 += v[q][j][i] * wf[2 * (4 * j + i)]; f1 += v[q][j][i] * wf[2 * (4 * j + i) + 1]; }
                float fl[8] = {f0[0], f0[1], f0[2], f0[3], f1[0], f1[1], f1[2], f1[3]};
#pragma unroll
                for (int h = 0; h < 4; ++h) { const float a = fl[h], b = fl[h + 4]; const bool up = (lane & 4) != 0; const float send = up ? a : b, keep = up ? b : a; fl[h] = keep + __shfl_xor(send, 4); }
#pragma unroll
                for (int h = 0; h < 2; ++h) { const float a = fl[h], b = fl[h + 2]; const bool up = (lane & 2) != 0; const float send = up ? a : b, keep = up ? b : a; fl[h] = keep + wr_dpp<0x4e>(send); }
                { const float a = fl[0], b = fl[1]; const bool up = (lane & 1) != 0; const float send = up ? a : b, keep = up ? b : a; fl[0] = keep + wr_dpp<0xb1>(send); }
                float mine = fl[0];
                mine += wr_dpp<0x128>(mine); mine = xsum32(xsum16(mine));
                const float z = mine + bfv;
                const float lf = fminf(z, 0.f) - log1pf(__expf(-fabsf(z)));
                if (lane < 8) dlogf[(size_t)(r + q) * NH + lane] = lf;
            }
        }
    }
}
#undef NR_LD
template <int KIND> __device__ __forceinline__ void norm_phase(Frame& F, int nskip) {
    unsigned char* const ws_ = WSP(); float* const out_ = OUTP();
    bf16* HN = (bf16*)(ws_ + WS_HN);
    if (KIND == 1) {
        const float* mp = (const float*)(ws_ + WS_MODP); float* mo = (float*)(ws_ + WS_MOD); const float* bada = INP(I_BADA);
        for (int e = (int)blockIdx.x * NWAVES * 64 + ((int)threadIdx.x); e < NB * MODW; e += F.G * NWAVES * 64)
            mo[e] = ((mp[e] + mp[e + (size_t)NB * MODW]) + (mp[e + 2 * (size_t)NB * MODW] + mp[e + 3 * (size_t)NB * MODW])) + bada[e % MODW];
    }
    const float* xpp = KIND == 1 ? INP(I_XP) : (const float*)(ws_ + WS_X);     const float* xsp = (const float*)(ws_ + WS_XSB);
    const float* part = (const float*)(ws_ + WS_PART); const int npart = 5;
    if ((int)blockIdx.x >= nskip) {
        const int nwv = (F.G - nskip) * NWAVES, gwp = ((int)blockIdx.x - nskip) * NWAVES + F.wave, R = ((MP + nwv - 1) / nwv + 1) & ~1;
        int a = gwp * R; const int bnd = a + R < MP ? a + R : MP;
        while (a < bnd) { const int bi = a / TP, e = (bi + 1) * TP < bnd ? (bi + 1) * TP : bnd;
            norm_rows<KIND, KIND != 1>(F, KIND == 1 ? xpp + (size_t)a * D : (const float*)((const bf16*)(const void*)xpp + (size_t)a * D), (KIND == 1 || KIND == 3) ? (bf16*)((unsigned char*)HN + (size_t)a * D) : HN + (size_t)a * D, out_ + O_YP + (size_t)a * D, out_ + O_LP + (size_t)a * NH, e - a, bi);
            a = e; }
    }
    if (KIND == 4) for (int r = 2 * (F.vcu * NWAVES + F.wave); r < MS; r += 2 * F.G * NWAVES) {
        const int bi = NBP + r / TS;
        const float* src = xsp + (size_t)r * D;
        norm_rows<KIND>(F, src, (KIND == 1 || KIND == 3) ? (bf16*)((unsigned char*)HN + (size_t)(MP + r) * D) : HN + (size_t)(MP + r) * D, out_ + O_YS + (size_t)r * D, out_ + O_LS + (size_t)r * NH, 2, bi, part + (size_t)r * D, npart, nullptr);
    }
}
__device__ __forceinline__ void sub_barrier(unsigned* ctr, unsigned n) {
    asm volatile("s_waitcnt vmcnt(0)" ::: "memory"); __syncthreads();
    if (threadIdx.x == 0) {
        __builtin_amdgcn_fence(__ATOMIC_RELEASE, "agent"); asm volatile("s_waitcnt vmcnt(0)" ::: "memory");
        (void)xb_add(ctr, 1u);
        unsigned sp = 0; while (xb_ld(ctr) < n) { __builtin_amdgcn_s_sleep(1); if (++sp > (1u << 22)) break; }
        __builtin_amdgcn_fence(__ATOMIC_ACQUIRE, "agent"); asm volatile("s_waitcnt vmcnt(0)" ::: "memory");
    }
    __syncthreads();
}
template <int KIND> __device__ __forceinline__ void sample_norm_shared(Frame& F, unsigned char* buf, int nblk, unsigned* ctr) {
    unsigned char* const ws_ = WSP(); float* const out_ = OUTP();
    const float* base = KIND == 3 ? (const float*)(ws_ + WS_XSA) : INP(I_XS);
    float* xw = KIND == 1 ? nullptr : KIND == 2 ? (float*)(ws_ + WS_XSA) : (float*)(ws_ + WS_XSB);
    const float* part = (const float*)(ws_ + WS_PART); const int npart = KIND == 1 ? 0 : KIND == 2 ? 5 : 4;
    const int rpw = nblk >= 16 ? 2 : 4, gw = (int)blockIdx.x * NWAVES + F.wave;
    if (gw * rpw < MS) { const int r = gw * rpw, bi = NBP + r / TS;
        bf16* dst = (KIND == 2) ? (bf16*)buf + (size_t)r * D : (bf16*)(buf + (size_t)r * D);
        norm_rows<KIND>(F, base + (size_t)r * D, dst, nullptr, out_ + O_LS + (size_t)r * NH, rpw, bi, part + (size_t)r * D, npart, xw ? xw + (size_t)r * D : nullptr); }
    sub_barrier(ctr, (unsigned)nblk);
}

__device__ __forceinline__ void sample_in_finish(Frame& F, int r) {
    unsigned char* const ws_ = WSP(); float* const out_ = OUTP();
    const int l = (int)(threadIdx.x & 63), j = l & 31, hw = l >> 5;
    const float* P = (const float*)(ws_ + WS_PART) + (size_t)r * NIN + l;
    bf16* A2 = (bf16*)(ws_ + WS_A2) + ((size_t)MP + r) * D; bf16* KB = (bf16*)(ws_ + WS_KB) + ((size_t)MP + r) * DATT; bf16* VB = (bf16*)(ws_ + WS_VB) + ((size_t)MP + r) * DATT; bf16* UB = (bf16*)(ws_ + WS_UB) + ((size_t)MP + r) * DCONV;
    const float gq0 = INP(I_GQ)[j], gq1 = INP(I_GQ)[32 + j], gk0 = INP(I_GK)[j], gk1 = INP(I_GK)[32 + j];
#pragma unroll 1
    for (int pn = 0; pn < NIN / 256; ++pn) {
        float v[4];
#pragma unroll
        for (int q = 0; q < 4; ++q) { const float* p = P + pn * 256 + 64 * q; v[q] = (p[0] + p[(size_t)256 * NIN]) + (p[(size_t)2 * 256 * NIN] + p[(size_t)3 * 256 * NIN]); }
        if (pn < 6) {
            const int sec = pn >> 1, hA = 4 * (pn & 1) + hw;
            if (sec < 2) { float sa = v[0] * v[0] + v[2] * v[2], sb = v[1] * v[1] + v[3] * v[3];
                sa = xsum16(row_sum16(sa)); sb = xsum16(row_sum16(sb));
                const float ra = __builtin_amdgcn_rsqf(sa * (1.0f / 64.0f) + 1e-6f), rb = __builtin_amdgcn_rsqf(sb * (1.0f / 64.0f) + 1e-6f);
                const float g0 = sec == 0 ? gq0 * attn_body::C2 : gk0, g1 = sec == 0 ? gq1 * attn_body::C2 : gk1;
                v[0] *= ra * g0; v[2] *= ra * g1; v[1] *= rb * g0; v[3] *= rb * g1; }
            if (sec == 0) { A2[hA * HD + j] = (bf16)f2bf(v[0]); A2[hA * HD + 32 + j] = (bf16)f2bf(v[2]); A2[(hA + 2) * HD + j] = (bf16)f2bf(v[1]); A2[(hA + 2) * HD + 32 + j] = (bf16)f2bf(v[3]); }
            else { bf16* db = sec == 1 ? KB : VB; float* df = out_ + (sec == 1 ? O_KS : O_VS) + (size_t)r * DATT;
                db[hA * HD + j] = (bf16)f2bf(v[0]); db[hA * HD + 32 + j] = (bf16)f2bf(v[2]); db[(hA + 2) * HD + j] = (bf16)f2bf(v[1]); db[(hA + 2) * HD + 32 + j] = (bf16)f2bf(v[3]);
                df[hA * HD + j] = v[0]; df[hA * HD + 32 + j] = v[2]; df[(hA + 2) * HD + j] = v[1]; df[(hA + 2) * HD + 32 + j] = v[3]; }
        } else {
            const int c0 = 128 * (pn - 6) + l; const float u0 = v[0] * pg8::ep_sigmoid(v[2]), u1 = v[1] * pg8::ep_sigmoid(v[3]);
            UB[c0] = (bf16)f2bf(u0); UB[c0 + 64] = (bf16)f2bf(u1);
            float* d = out_ + O_CS + ((size_t)(r >> 4) * CS + 14 + (r & 15)) * DCONV; d[c0] = u0; d[c0 + 64] = u1;
        }
    }
}

__device__ __forceinline__ void fscan_bh(Frame& F, int bh) {
    unsigned char* const ws_ = WSP(); float* const out_ = OUTP();
    LAS float* wtot = (LAS float*)(F.lds);
    const int b = bh >> 3, h = bh & 7, tid = (int)threadIdx.x, lane = tid & 63;
    const float* lf = out_ + O_LP + (size_t)b * TP * NH + h;
    float* FP = (float*)(ws_ + WS_FP) + (size_t)bh * TP;
    const int t0 = 16 * tid;
    float v[16], run = 0.f;
#pragma unroll
    for (int tt = 0; tt < 16; ++tt) { run += lf[(size_t)(t0 + tt) * NH]; v[tt] = run; }
    float inc = run;
#pragma unroll
    for (int o = 1; o < 64; o <<= 1) { const float n = __shfl_up(inc, o); if (lane >= o) inc += n; }
    if (lane == 63) wtot[F.wave] = inc;
    __syncthreads();
    float pre = inc - run;
    for (int w = 0; w < F.wave; ++w) pre += wtot[w];
#pragma unroll
    for (int q = 0; q < 4; ++q) *(f32x4*)(FP + t0 + 4 * q) = (f32x4){pre + v[4 * q], pre + v[4 * q + 1], pre + v[4 * q + 2], pre + v[4 * q + 3]};
    LAS float* Fend = wtot + 16; LAS float* Fq = Fend + 128;
    if ((tid & 3) == 3) Fend[tid >> 2] = pre + v[15];
    if ((tid & 15) == 0) Fq[tid >> 4] = pre + v[0];
    const float gqm = wave_max(fabsf(INP(I_GQ)[lane])), gkm = wave_max(fabsf(INP(I_GK)[lane]));
    const float skipt = 40.0f + 2.0f * (64.0f * 1.02f * attn_body::C2) * gqm * gkm;
    __syncthreads();
    if (tid < TP / 256) { int lo = 0, hh = 4 * tid; const float fq = Fq[tid];
        while (lo < hh) { const int mid = (lo + hh) >> 1; if ((fq - Fend[mid]) * LOG2E < -skipt) lo = mid + 1; else hh = mid; }
        ((int*)(ws_ + WS_J0))[bh * (TP / 256) + tid] = lo & ~1; }
    __syncthreads();
}

typedef float f32x2 __attribute__((ext_vector_type(2)));
typedef float f32x16 __attribute__((ext_vector_type(16)));
__device__ __forceinline__ f32x2 bfpair(unsigned x) { f32x2 r; r.x = __builtin_bit_cast(float, x << 16); r.y = __builtin_bit_cast(float, x & 0xffff0000u); return r; }
__device__ __forceinline__ void conv_unit(Frame& F, int u) {
    unsigned char* const ws_ = WSP();
    LAS float* ylds = (LAS float*)(F.lds);
    const int tid = threadIdx.x, cp = tid & 255, rh = tid >> 8;
    const bool smp = u >= 512;
    const int b = smp ? u - 512 : u >> 7, t0 = smp ? 0 : 64 * (u & 127), nrows = smp ? TS : 64, tmax = smp ? TS : TP;
    const int th0 = t0 + 32 * rh;
    const size_t rowbase = smp ? (size_t)MP + (size_t)b * TS : (size_t)b * TP;
    const unsigned* UBp = (const unsigned*)((const bf16*)(ws_ + WS_UB) + rowbase * DCONV) + cp;
    const float* st = INP(I_SCONV) + (size_t)b * CS * DCONV + 2 * cp;
    f32x2 w[CW]; const float* cwp = INP(I_CONVW);
#pragma unroll
    for (int j = 0; j < CW; ++j) w[j] = *(const f32x2*)(cwp + j * DCONV + 2 * cp);
    const f32x2 cb = *(const f32x2*)(INP(I_CONVB) + 2 * cp);
    f32x2 win[32];
#pragma unroll
    for (int s = 0; s < 32; ++s) { const int t = th0 - 32 + s; f32x2 v = (f32x2){0.f, 0.f};
        if (t >= 0) { if (t < tmax) v = bfpair(UBp[(size_t)t * 256]); } else if (smp && t >= -CS) v = *(const f32x2*)(st + (size_t)(CS + t) * DCONV);
        win[s] = v; }
    unsigned nw[32];
#pragma unroll
    for (int s = 0; s < 32; ++s) nw[s] = (th0 + s) < tmax ? UBp[(size_t)(th0 + s) * 256] : 0u;
#pragma unroll
    for (int s = 0; s < 32; ++s) { win[s] = bfpair(nw[s]); f32x2 a = cb;
#pragma unroll
        for (int j = 0; j < CW; ++j) a += w[j] * win[(s - 30 + j) & 31];
        *(LAS f32x2*)(ylds + (32 * rh + s) * DCONV + 2 * cp) = a; }
    __syncthreads();
    { const int lane = ((int)(threadIdx.x & 63)); const float* lng = INP(I_LNG); const float* lnb = INP(I_LNB); f32x4 g0 = *(const f32x4*)(lng + 8 * lane), g1 = *(const f32x4*)(lng + 8 * lane + 4), b0 = *(const f32x4*)(lnb + 8 * lane), b1 = *(const f32x4*)(lnb + 8 * lane + 4);
        bf16* A2 = (bf16*)(ws_ + WS_A2);
        for (int r = F.wave; r < nrows; r += NWAVES) {
            f32x4 y0 = *(const LAS f32x4*)(ylds + r * DCONV + 8 * lane), y1 = *(const LAS f32x4*)(ylds + r * DCONV + 8 * lane + 4);
            const float mu = wave_sum((y0[0] + y0[1]) + (y0[2] + y0[3]) + (y1[0] + y1[1]) + (y1[2] + y1[3])) * (1.0f / DCONV);
            y0 = y0 - mu; y1 = y1 - mu;
            const float var = wave_sum((y0[0] * y0[0] + y0[1] * y0[1]) + (y0[2] * y0[2] + y0[3] * y0[3]) + (y1[0] * y1[0] + y1[1] * y1[1]) + (y1[2] * y1[2] + y1[3] * y1[3])) * (1.0f / DCONV);
            const float rs = 1.0f / sqrtf(var + EPS);
            y0 = y0 * rs * g0 + b0; y1 = y1 * rs * g1 + b1;
            float o[8];
#pragma unroll
            for (int i = 0; i < 4; ++i) { o[i] = pg8::ep_silu(y0[i]); o[4 + i] = pg8::ep_silu(y1[i]); }
            v4u pk; pk.x = pk2(o[0], o[1]); pk.y = pk2(o[2], o[3]); pk.z = pk2(o[4], o[5]); pk.w = pk2(o[6], o[7]);
            *(GAS v4u*)(A2 + (rowbase + t0 + r) * D + DATT + 8 * lane) = pk;
        } }
    __syncthreads();
}

__device__ __forceinline__ void conv_run(Frame& F, int u0, int ustep, int uend) {
    if (u0 >= uend) return;
    unsigned char* const ws_ = WSP();
    LAS float* ylds = (LAS float*)(F.lds);
    const int tid = threadIdx.x, cp = tid & 255, rh = tid >> 8, lane = tid & 63;
    f32x2 w[CW]; const float* cwp = INP(I_CONVW);
#pragma unroll
    for (int j = 0; j < CW; ++j) w[j] = *(const f32x2*)(cwp + j * DCONV + 2 * cp);
    const f32x2 cb = *(const f32x2*)(INP(I_CONVB) + 2 * cp);
    const float* lng = INP(I_LNG); const float* lnb = INP(I_LNB);
    const f32x4 g0 = *(const f32x4*)(lng + 8 * lane), g1 = *(const f32x4*)(lng + 8 * lane + 4), b0 = *(const f32x4*)(lnb + 8 * lane), b1 = *(const f32x4*)(lnb + 8 * lane + 4);
    const unsigned* UB0 = (const unsigned*)(ws_ + WS_UB) + cp;
    bf16* A2 = (bf16*)(ws_ + WS_A2);
    unsigned pre[64];
#define CV_LOAD(u_) do { const int b_ = (u_) >> 7, th_ = 64 * ((u_) & 127) + 32 * rh - 32; const unsigned* p_ = UB0 + (size_t)b_ * TP * 256; \
        _Pragma("unroll") for (int s = 0; s < 64; ++s) { const int t_ = th_ + s; const unsigned v_ = p_[(size_t)(t_ < 0 ? 0 : t_) * 256]; pre[s] = t_ < 0 ? 0u : v_; } } while (0)
    CV_LOAD(u0);
#pragma unroll 1
    for (int u = u0; u < uend; u += ustep) {
        f32x2 win[32];
#pragma unroll
        for (int s = 0; s < 32; ++s) win[s] = bfpair(pre[s]);
#pragma unroll
        for (int s = 0; s < 32; ++s) { win[s] = bfpair(pre[32 + s]); f32x2 a = cb;
#pragma unroll
            for (int j = 0; j < CW; ++j) a += w[j] * win[(s - 30 + j) & 31];
            *(LAS f32x2*)(ylds + (32 * rh + s) * DCONV + 2 * cp) = a; }
        __syncthreads();
        if (u + ustep < uend) CV_LOAD(u + ustep);
        { const size_t row0 = (size_t)(u >> 7) * TP + 64 * (u & 127);
#pragma unroll 1
            for (int r = F.wave; r < 64; r += 2 * NWAVES) {
                f32x4 y[2][2]; float mu[2], var[2];
#pragma unroll
                for (int q = 0; q < 2; ++q) { y[q][0] = *(const LAS f32x4*)(ylds + (r + 8 * q) * DCONV + 8 * lane); y[q][1] = *(const LAS f32x4*)(ylds + (r + 8 * q) * DCONV + 8 * lane + 4);
                    mu[q] = (y[q][0][0] + y[q][0][1]) + (y[q][0][2] + y[q][0][3]) + (y[q][1][0] + y[q][1][1]) + (y[q][1][2] + y[q][1][3]); }
                mu[0] = wave_sum(mu[0]); mu[1] = wave_sum(mu[1]);
#pragma unroll
                for (int q = 0; q < 2; ++q) { mu[q] *= (1.0f / DCONV); y[q][0] = y[q][0] - mu[q]; y[q][1] = y[q][1] - mu[q];
                    var[q] = (y[q][0][0] * y[q][0][0] + y[q][0][1] * y[q][0][1]) + (y[q][0][2] * y[q][0][2] + y[q][0][3] * y[q][0][3]) + (y[q][1][0] * y[q][1][0] + y[q][1][1] * y[q][1][1]) + (y[q][1][2] * y[q][1][2] + y[q][1][3] * y[q][1][3]); }
                var[0] = wave_sum(var[0]); var[1] = wave_sum(var[1]);
#pragma unroll
                for (int q = 0; q < 2; ++q) { const float rs = 1.0f / sqrtf(var[q] * (1.0f / DCONV) + EPS);
                    const f32x4 z0 = y[q][0] * rs * g0 + b0, z1 = y[q][1] * rs * g1 + b1;
                    v4u pk; pk.x = pk2(pg8::ep_silu(z0[0]), pg8::ep_silu(z0[1])); pk.y = pk2(pg8::ep_silu(z0[2]), pg8::ep_silu(z0[3])); pk.z = pk2(pg8::ep_silu(z1[0]), pg8::ep_silu(z1[1])); pk.w = pk2(pg8::ep_silu(z1[2]), pg8::ep_silu(z1[3]));
                    *(GAS v4u*)(A2 + (row0 + r + 8 * q) * D + DATT + 8 * lane) = pk; }
            } }
        __syncthreads();
    }
#undef CV_LOAD
}

__device__ __forceinline__ void conv_run2(Frame& F, int hh0, int nh) {
    if (nh <= 0) return;
    unsigned char* const ws_ = WSP();
    LAS unsigned char* const inb = F.lds;
    LAS float* const ylds = (LAS float*)(F.lds + 65536);
    const int tid = threadIdx.x, cp = tid & 255, rh = tid >> 8, lane = tid & 63, wave = F.wave;
    f32x2 w[CW]; const float* cwp = INP(I_CONVW);
#pragma unroll
    for (int j = 0; j < CW; ++j) w[j] = *(const f32x2*)(cwp + j * DCONV + 2 * cp);
    const f32x2 cb = *(const f32x2*)(INP(I_CONVB) + 2 * cp);
    const bf16* UB = (const bf16*)(ws_ + WS_UB); bf16* A2 = (bf16*)(ws_ + WS_A2);
    const unsigned inb0 = (unsigned)(uintptr_t)inb;
#define CV_DMA(hh_, chunk_) do { const size_t r0_ = (size_t)(hh_) * 32 + 4 * wave; _Pragma("unroll") for (int k_ = 0; k_ < 4; ++k_) \
        attn_body::glds16(UB + (r0_ + k_) * DCONV + 8 * lane, (unsigned)__builtin_amdgcn_readfirstlane((int)(inb0 + (unsigned)(chunk_) * 32768u + (unsigned)(4 * wave + k_) * 1024u))); } while (0)
#define CV_ZERO(chunk_) do { _Pragma("unroll") for (int k_ = 0; k_ < 4; ++k_) *(LAS v4u*)(inb + (chunk_) * 32768 + k_ * 8192 + tid * 16) = (v4u){0u, 0u, 0u, 0u}; } while (0)
    { const int c = hh0 & 1; if ((hh0 & 255) == 0) CV_ZERO(c ^ 1); else CV_DMA(hh0 - 1, c ^ 1); CV_DMA(hh0, c); }
    asm volatile("s_waitcnt vmcnt(0) lgkmcnt(0)" ::: "memory"); __syncthreads();
#pragma unroll 1
    for (int i = 0; i < nh; ++i) { const int hh = hh0 + i, cur = hh & 1;
        { const int o0 = 16 * rh - 30;
            unsigned pre[46]; f32x2 win[32];
#pragma unroll
            for (int s = 0; s < 46; ++s) { const int off = o0 + s; pre[s] = *(const LAS unsigned*)(inb + ((off < 0 ? (cur ^ 1) : cur) * 32768 + (off & 31) * 1024 + cp * 4)); }
#pragma unroll
            for (int s = 0; s < 30; ++s) win[s] = bfpair(pre[s]);
#pragma unroll
            for (int s = 0; s < 16; ++s) { win[(s + 30) & 31] = bfpair(pre[s + 30]); f32x2 a = cb;
#pragma unroll
                for (int j = 0; j < CW; ++j) a += w[j] * win[(s + j) & 31];
                *(LAS f32x2*)(ylds + (16 * rh + s) * DCONV + 2 * cp) = a; } }
        __syncthreads();
        if (i + 1 < nh) { CV_DMA(hh + 1, cur ^ 1); if (((hh + 1) & 255) == 0) CV_ZERO(cur); }
        { const size_t row0 = (size_t)hh * 32; const float* lng = INP(I_LNG); const float* lnb = INP(I_LNB);
            const f32x4 g0 = *(const f32x4*)(lng + 8 * lane), g1 = *(const f32x4*)(lng + 8 * lane + 4), b0 = *(const f32x4*)(lnb + 8 * lane), b1 = *(const f32x4*)(lnb + 8 * lane + 4);
#pragma unroll 1
            for (int r = wave; r < 32; r += 2 * NWAVES) {
                f32x4 y[2][2]; float mu[2], var[2];
#pragma unroll
                for (int q = 0; q < 2; ++q) { y[q][0] = *(const LAS f32x4*)(ylds + (r + 8 * q) * DCONV + 8 * lane); y[q][1] = *(const LAS f32x4*)(ylds + (r + 8 * q) * DCONV + 8 * lane + 4);
                    mu[q] = (y[q][0][0] + y[q][0][1]) + (y[q][0][2] + y[q][0][3]) + (y[q][1][0] + y[q][1][1]) + (y[q][1][2] + y[q][1][3]); }
                mu[0] = wave_sum(mu[0]); mu[1] = wave_sum(mu[1]);
#pragma unroll
                for (int q = 0; q < 2; ++q) { mu[q] *= (1.0f / DCONV); y[q][0] = y[q][0] - mu[q]; y[q][1] = y[q][1] - mu[q];
                    var[q] = (y[q][0][0] * y[q][0][0] + y[q][0][1] * y[q][0][1]) + (y[q][0][2] * y[q][0][2] + y[q][0][3] * y[q][0][3]) + (y[q][1][0] * y[q][1][0] + y[q][1][1] * y[q][1][1]) + (y[q][1][2] * y[q][1][2] + y[q][1][3] * y[q][1][3]); }
                var[0] = wave_sum(var[0]); var[1] = wave_sum(var[1]);
#pragma unroll
                for (int q = 0; q < 2; ++q) { const float rs = 1.0f / sqrtf(var[q] * (1.0f / DCONV) + EPS);
                    const f32x4 z0 = y[q][0] * rs * g0 + b0, z1 = y[q][1] * rs * g1 + b1;
                    v4u pk; pk.x = pk2(pg8::ep_silu(z0[0]), pg8::ep_silu(z0[1])); pk.y = pk2(pg8::ep_silu(z0[2]), pg8::ep_silu(z0[3])); pk.z = pk2(pg8::ep_silu(z1[0]), pg8::ep_silu(z1[1])); pk.w = pk2(pg8::ep_silu(z1[2]), pg8::ep_silu(z1[3]));
                    *(GAS v4u*)(A2 + (row0 + r + 8 * q) * D + DATT + 8 * lane) = pk; }
            } }
        asm volatile("s_waitcnt vmcnt(0) lgkmcnt(0)" ::: "memory"); __syncthreads();
    }
#undef CV_DMA
#undef CV_ZERO
}

__device__ __forceinline__ bf16x8 pack8(f32x4 a, f32x4 b) { v4u w; w.x = pg8::cvt_pk_bf16(a[0], a[1]); w.y = pg8::cvt_pk_bf16(a[2], a[3]); w.z = pg8::cvt_pk_bf16(b[0], b[1]); w.w = pg8::cvt_pk_bf16(b[2], b[3]); return __builtin_bit_cast(bf16x8, w); }
__device__ __forceinline__ void sattn_unit(Frame& F, int b, int h, bf16* OB) {
    unsigned char* const ws_ = WSP(); float* const out_ = OUTP();
    LAS float* bias = (LAS float*)(F.lds);
    LAS float* wtot = bias + 2080;
    LAS float* wsf = wtot + 16;
    LAS float* mw = wsf + 128;
    LAS float* lw = mw + 128;
    LAS float* ow = lw + 128;
    const int tid = threadIdx.x, lane = tid & 63, r32 = lane & 31, hi = lane >> 5, wave = F.wave;
    { const float* clf = INP(I_CLF) + (size_t)b * PAST * NH + h; float v[4], run = 0.f;
#pragma unroll
        for (int i = 0; i < 4; ++i) { run += clf[(size_t)(4 * tid + i) * NH]; v[i] = run; }
        float inc = run;
#pragma unroll
        for (int o = 1; o < 64; o <<= 1) { const float n = __shfl_up(inc, o); if (lane >= o) inc += n; }
        if (lane == 63) wtot[wave] = inc;
        __syncthreads();
        float pre = inc - run, total = 0.f;
        for (int w = 0; w < NWAVES; ++w) { const float x = wtot[w]; if (w < wave) pre += x; total += x; }
#pragma unroll
        for (int i = 0; i < 4; ++i) bias[4 * tid + i] = (total - (pre + v[i])) * LOG2E;
        if (tid == 0) { const float* lfn = out_ + O_LS + (size_t)b * TS * NH + h; float r2 = 0.f; for (int i = 0; i < TS; ++i) { r2 += lfn[i * NH]; bias[PAST + i] = -r2 * LOG2E; } }
        if (tid >= 16 && tid < 32) bias[PAST + tid] = 0.f;
    }
    __syncthreads();
    bf16x8 qf[4];
    { const bf16* qp = (const bf16*)(ws_ + WS_A2) + ((size_t)MP + b * TS + (r32 & 15)) * D + h * HD + 8 * hi;
#pragma unroll
        for (int d0 = 0; d0 < 4; ++d0) { const bf16x8 v = *(const bf16x8*)(qp + 16 * d0); qf[d0] = r32 < 16 ? v : (bf16x8){0, 0, 0, 0, 0, 0, 0, 0}; } }
    const float* kc = INP(I_CK) + ((size_t)b * PAST * NH + h) * HD; const float* vc = INP(I_CV) + ((size_t)b * PAST * NH + h) * HD;
    const float* kn = out_ + O_KS + ((size_t)b * TS * NH + h) * HD; const float* vn = out_ + O_VS + ((size_t)b * TS * NH + h) * HD;
    const int nit = wave == 0 ? 9 : 8;
    f32x4 Kr[8]; f32x4 Vq[8];
    LAS char* const vt = (LAS char*)(ow + 8192) + wave * 4096;
    const attn_body::lds_cptr vtr0 = (attn_body::lds_cptr)vt + ((lane >> 4) & 1) * 32 + (lane & 3) * 8 + (4 * hi + ((lane & 15) >> 2)) * 64;
#define SA_LOAD(it) do { const bool nw_ = (it) == 8; const int kb_ = nw_ ? 0 : 256 * wave + 32 * (it); \
        const float* kp_ = (nw_ ? kn : kc) + (size_t)(kb_ + (nw_ ? (r32 & 15) : r32)) * (NH * HD) + 8 * hi; \
        _Pragma("unroll") for (int d0 = 0; d0 < 4; ++d0) { Kr[2 * d0] = __builtin_nontemporal_load((const f32x4*)(kp_ + 16 * d0)); Kr[2 * d0 + 1] = __builtin_nontemporal_load((const f32x4*)(kp_ + 16 * d0 + 4)); } \
        const float* vp_ = (nw_ ? vn : vc) + (size_t)kb_ * (NH * HD) + 4 * (lane & 15); \
        _Pragma("unroll") for (int i_ = 0; i_ < 8; ++i_) { int key_ = 4 * i_ + (lane >> 4); if (nw_) key_ &= 15; Vq[i_] = __builtin_nontemporal_load((const f32x4*)(vp_ + (size_t)key_ * (NH * HD))); } } while (0)
    SA_LOAD(0);
    float m = -INFINITY, l = 0.f; f32x16 o[2]; o[0] = f32x16{}; o[1] = f32x16{};
#pragma unroll 1
    for (int it = 0; it < nit; ++it) {
        bf16x8 kf[4], vf[4];
#pragma unroll
        for (int d0 = 0; d0 < 4; ++d0) kf[d0] = pack8(Kr[2 * d0], Kr[2 * d0 + 1]);
#pragma unroll
        for (int i = 0; i < 8; ++i) { typedef unsigned u32x2v __attribute__((ext_vector_type(2)));
            *(LAS u32x2v*)(vt + ((lane & 15) >> 3) * 2048 + (4 * i + (lane >> 4)) * 64 + (lane & 7) * 8) = (u32x2v){pg8::cvt_pk_bf16(Vq[i][0], Vq[i][1]), pg8::cvt_pk_bf16(Vq[i][2], Vq[i][3])}; }
        asm volatile("s_waitcnt lgkmcnt(0)" ::: "memory");
#pragma unroll
        for (int q = 0; q < 4; ++q) { const attn_body::s16x4 lo_ = attn_body::vtr(vtr0 + (q & 1) * 2048 + (q >> 1) * 1024), hi_ = attn_body::vtr(vtr0 + (q & 1) * 2048 + (q >> 1) * 1024 + 512);
            vf[q] = (bf16x8){lo_[0], lo_[1], lo_[2], lo_[3], hi_[0], hi_[1], hi_[2], hi_[3]}; }
        if (it + 1 < nit) SA_LOAD(it + 1);
        const bool nwk = it == 8; const int bidx = nwk ? PAST : 256 * wave + 32 * it;
        f32x16 S;
#pragma unroll
        for (int g = 0; g < 4; ++g) { const f32x4 x = *(const LAS f32x4*)(bias + bidx + 4 * hi + 8 * g);
#pragma unroll
            for (int i = 0; i < 4; ++i) S[4 * g + i] = x[i]; }
#pragma unroll
        for (int d0 = 0; d0 < 4; ++d0) S = __builtin_amdgcn_mfma_f32_32x32x16_bf16(kf[d0], qf[d0], S, 0, 0, 0);
        if (nwk) {
#pragma unroll
            for (int r = 0; r < 16; ++r) { const int key = (r & 3) + 8 * (r >> 2) + 4 * hi; if (key > r32 || key >= TS) S[r] = -INFINITY; } }
        float rm = S[0];
#pragma unroll
        for (int r = 1; r < 16; ++r) rm = fmaxf(rm, S[r]);
        rm = xmax32(rm);
        const float mn = fmaxf(m, rm), al = __builtin_amdgcn_exp2f(m - mn); m = mn;
        float rs = 0.f;
#pragma unroll
        for (int r = 0; r < 16; ++r) { S[r] = __builtin_amdgcn_exp2f(S[r] - mn); rs += S[r]; }
        l = l * al + rs;
        if (hi == 0 && r32 < 16) wsf[wave * 16 + r32] = al;
        asm volatile("s_waitcnt lgkmcnt(0)" ::: "memory");
        const f32x4 a0 = *(const LAS f32x4*)(wsf + wave * 16 + 4 * hi), a1 = *(const LAS f32x4*)(wsf + wave * 16 + 8 + 4 * hi);
#pragma unroll
        for (int dh = 0; dh < 2; ++dh)
#pragma unroll
            for (int i = 0; i < 4; ++i) { o[dh][i] *= a0[i]; o[dh][4 + i] *= a1[i]; }
        const bf16x8 pw0 = pack8((f32x4){S[0], S[1], S[2], S[3]}, (f32x4){S[4], S[5], S[6], S[7]}), pw1 = pack8((f32x4){S[8], S[9], S[10], S[11]}, (f32x4){S[12], S[13], S[14], S[15]});
#pragma unroll
        for (int dh = 0; dh < 2; ++dh) { o[dh] = __builtin_amdgcn_mfma_f32_32x32x16_bf16(pw0, vf[dh], o[dh], 0, 0, 0); o[dh] = __builtin_amdgcn_mfma_f32_32x32x16_bf16(pw1, vf[2 + dh], o[dh], 0, 0, 0); }
    }
#undef SA_LOAD
    l = xsum32(l);
    if (hi == 0 && r32 < 16) { mw[wave * 16 + r32] = m; lw[wave * 16 + r32] = l; }
#pragma unroll
    for (int dh = 0; dh < 2; ++dh)
#pragma unroll
        for (int r = 0; r < 8; ++r) ow[(wave * 16 + (r & 3) + 8 * (r >> 2) + 4 * hi) * 64 + 32 * dh + r32] = o[dh][r];
    __syncthreads();
    for (int e = tid; e < TS * HD; e += NWAVES * 64) { const int q = e >> 6; float M = -INFINITY;
#pragma unroll
        for (int w = 0; w < NWAVES; ++w) M = fmaxf(M, mw[w * 16 + q]);
        float num = 0.f, den = 0.f;
#pragma unroll
        for (int w = 0; w < NWAVES; ++w) { const float f = __builtin_amdgcn_exp2f(mw[w * 16 + q] - M); num += ow[w * 1024 + e] * f; den += lw[w * 16 + q] * f; }
        OB[((size_t)MP + b * TS + q) * D + h * HD + (e & 63)] = (bf16)f2bf(num / den); }
    __syncthreads();
}
struct AttnQueue {
    unsigned* ctr; const unsigned* flag; const unsigned short* order; volatile LAS unsigned* slot;
    __device__ __forceinline__ bool next(int, attn_body::AttnUnit& u) const {
        if (threadIdx.x == 0) {
            if (slot[2] == 0u) { unsigned sp = 0; while (__hip_atomic_load(flag, __ATOMIC_RELAXED, __HIP_MEMORY_SCOPE_AGENT) == 0u) { __builtin_amdgcn_s_sleep(2); if (++sp > (1u << 22)) break; }
                __builtin_amdgcn_fence(__ATOMIC_ACQUIRE, "agent"); slot[2] = 1u; }
            const unsigned k = __hip_atomic_fetch_add(ctr, 1u, __ATOMIC_RELAXED, __HIP_MEMORY_SCOPE_AGENT);
            slot[0] = k < (unsigned)(attn_body::BATCH * attn_body::NHEAD * attn_body::NQB) ? (unsigned)__hip_atomic_load(order + k, __ATOMIC_RELAXED, __HIP_MEMORY_SCOPE_AGENT) : 0xffffffffu; }
        __syncthreads();
        const unsigned k = (unsigned)__builtin_amdgcn_readfirstlane((int)slot[0]);
        __syncthreads();
        u.qb = (int)(k & 31u); u.bh = (int)((k >> 5) & 31u);
        return k != 0xffffffffu;
    }
    __device__ __forceinline__ void a_ready(const attn_body::AttnUnit&) const {}
    __device__ __forceinline__ void done(const attn_body::AttnUnit&) const {}
};
__device__ __forceinline__ void attn_sort(Frame& F, unsigned* flag) {
    unsigned char* const ws_ = WSP();
    LAS unsigned* hist = (LAS unsigned*)(F.lds);
    const int tid = (int)threadIdx.x; const int* j0tab = (const int*)(ws_ + WS_J0); unsigned short* order = (unsigned short*)(ws_ + WS_J0 + 8192);
    if (__builtin_amdgcn_readfirstlane((int)__hip_atomic_load(flag, __ATOMIC_RELAXED, __HIP_MEMORY_SCOPE_AGENT)) != 0) return;
    if (tid < 64) hist[tid] = 0u;
    __syncthreads();
    int key[2];
#pragma unroll
    for (int q = 0; q < 2; ++q) { const int u = 2 * tid + q; const int nt = 4 * (u & 31) + 4 - j0tab[u]; key[q] = 64 - (nt >> 1); __hip_atomic_fetch_add(hist + key[q], 1u, __ATOMIC_RELAXED, __HIP_MEMORY_SCOPE_WORKGROUP); }
    __syncthreads();
    if (tid == 0) { unsigned run = 0; for (int b = 0; b < 64; ++b) { const unsigned c = hist[b]; hist[b] = run; run += c; } }
    __syncthreads();
#pragma unroll
    for (int q = 0; q < 2; ++q) { const unsigned pos = __hip_atomic_fetch_add(hist + key[q], 1u, __ATOMIC_RELAXED, __HIP_MEMORY_SCOPE_WORKGROUP); order[pos] = (unsigned short)(2 * tid + q); }
    asm volatile("s_waitcnt vmcnt(0)" ::: "memory"); __syncthreads();
    if (tid == 0) { __builtin_amdgcn_fence(__ATOMIC_RELEASE, "agent"); asm volatile("s_waitcnt vmcnt(0)" ::: "memory"); __hip_atomic_store(flag, 1u, __ATOMIC_RELAXED, __HIP_MEMORY_SCOPE_AGENT); }
    __syncthreads();
}

struct Args { const float* in[N_IN]; float* out; unsigned char* ws; int ph_lo, ph_hi, li, pad; };
__global__ void __launch_bounds__(NWAVES * 64, 2) fox_fwd(Args args) {
    extern __shared__ __attribute__((aligned(16))) unsigned char lds[];
    Frame F;
    F.lds = (LAS unsigned char*)lds;
    F.MISC = (volatile LAS unsigned*)(F.lds + MISC_OFF);
    F.wave = __builtin_amdgcn_readfirstlane((int)threadIdx.x >> 6);
    F.G = gridDim.x; { const int bx = blockIdx.x; F.vcu = (F.G % 8 == 0) ? (bx % 8) * (F.G / 8) + bx / 8 : bx; }
    for (int u = ((int)threadIdx.x); u < (LDS_BYTES - LDSCTL_OFF) / 4; u += NWAVES * 64) ((LAS unsigned*)(F.lds + LDSCTL_OFF))[u] = 0u;
    __syncthreads();
    if (N_LAUNCHES == 1) (void)xcd_barrier_post((unsigned*)(WSP() + WS_CTL) + CW_BAR, F.MISC + 8);

#define X ((bf16*)(WSP() + WS_X))
#define MOD ((float*)(WSP() + WS_MOD))
#define HN ((bf16*)(WSP() + WS_HN))
#define HID ((bf16*)(WSP() + WS_HID))
#define A2 ((bf16*)(WSP() + WS_A2))
    const int lo = args.ph_lo, hi = args.ph_hi;
#define IN(k) (lo <= (k) && (k) < hi)
#ifndef EXTRA_BAR_AT
#define EXTRA_BAR_AT 99
#endif
#ifndef EXTRA_BAR
#define EXTRA_BAR 0
#endif
#define SEAM(k) do { if (IN((k) + 1)) { for (int xb_ = 0; xb_ < ((k) == EXTRA_BAR_AT ? EXTRA_BAR : 0); ++xb_) { XcdBarrier bar0; bar0.bar = (unsigned*)(WSP() + WS_CTL) + CW_BAR; bar0.x = xb_xcc_id(); bar0.st = F.MISC + 8; xcd_barrier(bar0); } XcdBarrier bar; bar.bar = (unsigned*)(WSP() + WS_CTL) + CW_BAR; bar.x = xb_xcc_id(); bar.st = F.MISC + 8; xcd_barrier(bar); } } while (0)
#ifndef UP_ALIGN
#define UP_ALIGN true
#endif
#ifndef UP_SP2
#define UP_SP2 true
#endif
#define GEMM_UP(WOFF) do { pg8::Gemm g{HN, (const bf16*)(WSP() + (WOFF)), M, NUP, D}; pg8::StaticOrder S; S.init(MP, NUP, F.G, (int)blockIdx.x, D / 128); pg8::EpiSwiGLU E{(unsigned char*)HID, 1.0f / 64.0f}; \
        pg8::gemm_phase<pg8::EpiSwiGLU, pg8::StaticOrder, UP_ALIGN, UP_SP2, true>(F.lds + RING_OFF, g, S, E); } while (0)
#define SAMPLE_UP(KIND_, WOFF) do { if ((int)blockIdx.x < NUP / 256) { unsigned char* priv_ = WSP() + WS_SPRIV; sample_norm_shared<KIND_>(F, priv_, NUP / 256, (unsigned*)(WSP() + WS_CTL) + CW_SUB + 64 * (KIND_) + (args.pad == 55 ? 256 : 0)); \
        pg8::Gemm g{(const bf16*)(priv_ - (size_t)MP * D), (const bf16*)(WSP() + (WOFF)), M, NUP, D}; pg8::OneUnit S{MP / 256, (int)blockIdx.x, D / 128}; pg8::EpiSwiGLU E{(unsigned char*)HID, 1.0f / 64.0f}; \
        pg8::gemm_phase<pg8::EpiSwiGLU, pg8::OneUnit, true, true, true>(F.lds + RING_OFF, g, S, E); } } while (0)
#define GEMM_RES(FP8_, BBF_, A_, WOFF, K_, NTK_, BP, CHUNK, COEF) do { pg8::Gemm g{(A_), (const bf16*)(WSP() + (WOFF)), M, D, (K_)}; pg8::SplitOrder S; S.init(MP, D, F.G, (int)blockIdx.x, (NTK_), 4); \
        pg8::EpiResid<BBF_> E{(const void*)(BP), (args.pad == 77 ? HN : X), MOD + (CHUNK) * D, (COEF), (float*)(WSP() + WS_PART)};     \
        pg8::gemm_phase<pg8::EpiResid<BBF_>, pg8::SplitOrder, true, true, FP8_>(F.lds + RING_OFF, g, S, E); } while (0)
    if (IN(0)) { p0_prologue(F); SEAM(0); }
    if (IN(1)) { SAMPLE_UP(1, WS_WUP1); norm_phase<1>(F, NUP / 256); SEAM(1); }
#ifdef PROBE_NULLEPI
    if (IN(2) && args.pad == 99) { pg8::Gemm g{HN, (const bf16*)(WSP() + WS_WUP1), M, NUP, D}; pg8::StaticOrder S; S.init(M, NUP, F.G, (int)blockIdx.x, D / 128); pg8::EpiNull E{(float*)(WSP() + WS_PART)};
        pg8::gemm_phase<pg8::EpiNull, pg8::StaticOrder, true, true, true>(F.lds + RING_OFF, g, S, E); }
    else
#endif
    if (IN(2)) { GEMM_UP(WS_WUP1); SEAM(2); }
    if (IN(3)) { GEMM_RES(true, false, HID, WS_WDN1, FF, FF / 128, INP(I_XP), 2, 0.5f / 64.0f); SEAM(3); }
#ifndef DIS_N2
    if (IN(4)) {
        constexpr int NPW = (NIN / 256) * 4;
        if ((int)blockIdx.x < NPW) { unsigned char* priv_ = WSP() + WS_SPRIV; const unsigned cb_ = (args.pad == 55 ? 256u : 0u);
            sample_norm_shared<2>(F, priv_, NPW, (unsigned*)(WSP() + WS_CTL) + CW_SUB + 64 * 2 + cb_);
            pg8::Gemm g{(const bf16*)priv_ - (size_t)MP * D, (const bf16*)(WSP() + WS_WIN), M, NIN, D}; pg8::PieceOrder S{MP / 256, NIN / 256, 4, 4, (int)blockIdx.x};
            pg8::EpiPart E{(float*)(WSP() + WS_PART), NIN};
            pg8::gemm_phase<pg8::EpiPart, pg8::PieceOrder, true, true>(F.lds + RING_OFF, g, S, E);
            sub_barrier((unsigned*)(WSP() + WS_CTL) + CW_SUB + 64 * 5 + cb_, NPW);
            { const int r = (int)blockIdx.x * NWAVES + F.wave; if (r < MS) sample_in_finish(F, r); } }
        norm_phase<2>(F, NPW); SEAM(4); }
#endif
#ifdef PROBE_NULLIN
    if (IN(5) && args.pad == 98) { pg8::Gemm g{HN, (const bf16*)(WSP() + WS_WIN), M, NIN, D}; pg8::StaticOrder S; S.init(MP, NIN, F.G, (int)blockIdx.x, D / 64); pg8::EpiNull E{(float*)(WSP() + WS_PART)};
        pg8::gemm_phase<pg8::EpiNull, pg8::StaticOrder, true, true>(F.lds + RING_OFF, g, S, E); }
    else
#endif
    if (IN(5)) {
        for (int bh = blockIdx.x; bh < NBP * NH; bh += F.G) fscan_bh(F, bh);
        pg8::Gemm g{HN, (const bf16*)(WSP() + WS_WIN), M, NIN, D}; pg8::StaticOrder S; S.init(MP, NIN, F.G, (int)blockIdx.x, D / 64);
        pg8::EpiIn E{A2, (bf16*)(WSP() + WS_KB), (bf16*)(WSP() + WS_VB), (bf16*)(WSP() + WS_UB), OUTP(), INP(I_GQ), INP(I_GK), attn_body::C2, O_KP, O_VP, O_KS, O_VS, O_CP, O_CS, (args.pad >= 90 && args.pad <= 93) ? args.pad - 90 : 0};
        pg8::gemm_phase<pg8::EpiIn, pg8::StaticOrder, true, true>(F.lds + RING_OFF, g, S, E);
        SEAM(5);
    }
    if (IN(6)) {
        const int half = F.G / 2; const int sub = args.pad;
        bf16* const OB = (sub & 8) ? HN : A2;
        if ((int)blockIdx.x < half) { if (sub & 1) for (int u = blockIdx.x; u < NBS * NH; u += half) sattn_unit(F, u >> 3, u & 7, OB);
            if ((sub & 2) && (blockIdx.x & 1)) conv_run2(F, 2 * (int)(blockIdx.x >> 1), (int)(blockIdx.x >> 1) < 64 ? 2 : 0); }
        else { if ((sub & 4) && (int)blockIdx.x == F.G - 1) attn_sort(F, (unsigned*)(WSP() + WS_CTL) + CW_AQ + 128);
            if (sub & 2) { const int per_ = (1024 - 128 + (F.G - half) - 1) / (F.G - half), h0_ = 128 + ((int)blockIdx.x - half) * per_; conv_run2(F, h0_, h0_ + per_ <= 1024 ? per_ : 1024 - h0_);     for (int u = 512 + (int)blockIdx.x - half; u < 512 + NBS; u += F.G - half) conv_unit(F, u); } }
        if (sub & 4) {
        const attn_body::AttnTensors AT{(const attn_body::bf16*)A2, (const attn_body::bf16*)(WSP() + WS_KB), (const attn_body::bf16*)(WSP() + WS_VB), (attn_body::bf16*)OB, (const float*)(WSP() + WS_FP), (const int*)(WSP() + WS_J0), (64.0f * 1.02f * attn_body::C2) * wave_max(fabsf(INP(I_GQ)[threadIdx.x & 63])) * wave_max(fabsf(INP(I_GK)[threadIdx.x & 63]))};
        const AttnQueue S{(unsigned*)(WSP() + WS_CTL) + CW_AQ + 64 * (sub >> 4), (const unsigned*)(WSP() + WS_CTL) + CW_AQ + 128, (const unsigned short*)(WSP() + WS_J0 + 8192), F.MISC + 16};
#ifndef ATT_THRL
#define ATT_THRL 8
#endif
        attn_body::attn_phase<AttnQueue, ATT_THRL>((char*)lds + RING_OFF, AT, S);
        }
        SEAM(6);
    }
    if (IN(7)) { GEMM_RES(false, true, A2, WS_WOUT, D, D / 64, X, 5, 1.0f); SEAM(7); }
    if (IN(8)) { SAMPLE_UP(3, WS_WUP2); norm_phase<3>(F, NUP / 256); SEAM(8); }
    if (IN(9)) { GEMM_UP(WS_WUP2); SEAM(9); }
    if (IN(10)) { GEMM_RES(true, true, HID, WS_WDN2, FF, FF / 128, X, 8, 0.5f / 64.0f); SEAM(10); }
    if (IN(11)) { norm_phase<4>(F, 0); }
#undef IN
#undef SEAM
#undef X
#undef MOD
#undef HN
#undef HID
#undef A2
}

extern "C" void kernel_launch(void* const* d_in, const int* in_sizes, int n_in, void* d_out, int out_size, void* d_ws, size_t ws_size, hipStream_t stream) {
    static int grid = 0;
    if (grid == 0) {
        if (n_in != N_IN || in_sizes[0] != MP * D || (size_t)out_size != O_END || ws_size < WS_END) { fprintf(stderr, "kernel_launch: unexpected shapes (n_in %d, in0 %d, out %d, ws %zu); nothing launched\n", n_in, n_in > 0 ? in_sizes[0] : -1, out_size, ws_size); grid = -1; return; }
        int dev = 0, cus = 0, per_cu = 0;
        if (hipGetDevice(&dev) != hipSuccess || hipDeviceGetAttribute(&cus, hipDeviceAttributeMultiprocessorCount, dev) != hipSuccess) { fprintf(stderr, "kernel_launch: device query failed\n"); grid = -1; return; }
        if (hipFuncSetAttribute((const void*)fox_fwd, hipFuncAttributeMaxDynamicSharedMemorySize, LDS_BYTES) != hipSuccess) { fprintf(stderr, "kernel_launch: hipFuncSetAttribute failed\n"); grid = -1; return; }
        if (hipOccupancyMaxActiveBlocksPerMultiprocessor(&per_cu, (const void*)fox_fwd, NWAVES * 64, LDS_BYTES) != hipSuccess || per_cu < 1) { fprintf(stderr, "kernel_launch: occupancy query reports %d workgroups per CU; nothing launched\n", per_cu); (void)hipGetLastError(); grid = -1; return; }
        grid = cus;
    }
    if (grid < 0) return;
    if (hipMemsetAsync((char*)d_ws + WS_CTL, 0, CTL_ZERO_BYTES, stream) != hipSuccess) { fprintf(stderr, "kernel_launch: memset failed\n"); return; }
    Args a{};
    for (int i = 0; i < N_IN; ++i) a.in[i] = (const float*)d_in[i];
    a.out = (float*)d_out; a.ws = (unsigned char*)d_ws; a.pad = 7;
    if (N_LAUNCHES == 1) {
        a.ph_lo = 0; a.ph_hi = N_PHASES; a.li = 0;
        void* kargs[] = {&a};
        const hipError_t le = hipLaunchCooperativeKernel((const void*)fox_fwd, dim3(grid), dim3(NWAVES * 64), kargs, LDS_BYTES, stream);
        if (le != hipSuccess) fprintf(stderr, "kernel_launch: cooperative launch failed: %s (grid %d)\n", hipGetErrorName(le), grid);
    } else {
        for (int li = 0; li < N_PHASES; ++li) { a.ph_lo = li; a.ph_hi = li + 1; a.li = li;
            hipLaunchKernelGGL(fox_fwd, dim3(grid), dim3(NWAVES * 64), LDS_BYTES, stream, a);
#ifdef PROBE_DUP
            if ((PROBE_DUP >> li) & 1) hipLaunchKernelGGL(fox_fwd, dim3(grid), dim3(NWAVES * 64), LDS_BYTES, stream, a);
#endif
#ifdef PROBE_NULLEPI
            if (li == 2) { Args p = a; p.pad = 99; hipLaunchKernelGGL(fox_fwd, dim3(grid), dim3(NWAVES * 64), LDS_BYTES, stream, p); }
#endif
#ifdef PROBE_DUPN
            if ((PROBE_DUPN >> li) & 1) { Args p = a; p.pad = 55; hipLaunchKernelGGL(fox_fwd, dim3(grid), dim3(NWAVES * 64), LDS_BYTES, stream, p); }
#endif
#ifdef PROBE_NULLIN
            if (li == 5) { Args p = a; p.pad = 98; hipLaunchKernelGGL(fox_fwd, dim3(grid), dim3(NWAVES * 64), LDS_BYTES, stream, p); }
#endif
#ifdef PROBE_INV
            if (li == 5) { Args p = a; p.pad = 90 + PROBE_INV; hipLaunchKernelGGL(fox_fwd, dim3(grid), dim3(NWAVES * 64), LDS_BYTES, stream, p); }
#endif
#ifdef PROBE_P7
            if (li == 6) { Args p = a; p.ph_lo = 7; p.ph_hi = 8; p.pad = 77; hipLaunchKernelGGL(fox_fwd, dim3(grid), dim3(NWAVES * 64), LDS_BYTES, stream, p); }
#endif
#ifdef PROBE_SUB6
            if (li == 5) { Args p = a; p.ph_lo = 6; p.ph_hi = 7; p.pad = PROBE_SUB6 | 16; hipLaunchKernelGGL(fox_fwd, dim3(grid), dim3(NWAVES * 64), LDS_BYTES, stream, p); }
#endif
            const hipError_t le = hipPeekAtLastError(); if (le != hipSuccess) { fprintf(stderr, "kernel_launch: launch %d failed: %s\n", li, hipGetErrorName(le)); break; } }
    }
}
```

```cpp
#include <hip/hip_runtime.h>
#include <hip/hip_bf16.h>
#include <cstdio>
#include <cstdint>
#include <cmath>
template <int CTRL> __device__ __forceinline__ float wr_dpp(float v) { return __builtin_bit_cast(float, __builtin_amdgcn_update_dpp(0, __builtin_bit_cast(int, v), CTRL, 0xf, 0xf, true)); }
__device__ __forceinline__ float row_sum16(float v) { v += wr_dpp<0xb1>(v); v += wr_dpp<0x4e>(v); v += wr_dpp<0x124>(v); v += wr_dpp<0x128>(v); return v; }
__device__ __forceinline__ float row_max16(float v) { v = fmaxf(v, wr_dpp<0xb1>(v)); v = fmaxf(v, wr_dpp<0x4e>(v)); v = fmaxf(v, wr_dpp<0x124>(v)); v = fmaxf(v, wr_dpp<0x128>(v)); return v; }
#define WR_SWAP16(a, b) asm volatile("s_nop 1\n\tv_permlane16_swap_b32 %0, %1" : "+v"(a), "+v"(b))
#define WR_SWAP32(a, b) asm volatile("s_nop 1\n\tv_permlane32_swap_b32 %0, %1" : "+v"(a), "+v"(b))
__device__ __forceinline__ float xsum16(float v) { float a = v, b = v; WR_SWAP16(a, b); return a + b; }
__device__ __forceinline__ float xsum32(float v) { float a = v, b = v; WR_SWAP32(a, b); return a + b; }
__device__ __forceinline__ float xmax16(float v) { float a = v, b = v; WR_SWAP16(a, b); return fmaxf(a, b); }
__device__ __forceinline__ float xmax32(float v) { float a = v, b = v; WR_SWAP32(a, b); return fmaxf(a, b); }
namespace pg8 {
#define PG8_LAS __attribute__((address_space(3)))
typedef unsigned short bf16_t;
typedef short bf16x8 __attribute__((ext_vector_type(8)));
typedef float f32x4 __attribute__((ext_vector_type(4)));
typedef unsigned u32x4 __attribute__((ext_vector_type(4)));
constexpr int BM = 256, BK = 64, HALF = 128, HTB = HALF * BK * 2  , STAGE_BYTES = 8 * HTB, NXCD = 8, WGM = 8;

__host__ __device__ __forceinline__ int lds_byte(int r, int c) { const int st = (r >> 4) * 2 + (c >> 5), rr = r & 15, cc = c & 31, ob = rr * 64 + cc * 2; return st * 1024 + (ob ^ (((ob >> 9) & 1) << 5)); }
__host__ __device__ __forceinline__ void stage_rc(int b, int& R, int& C) { const int st = b / 1024, sb = b % 1024, swz = sb ^ (((sb >> 9) & 1) << 5); R = (st >> 1) * 16 + swz / 64; C = (st & 1) * 32 + (swz % 64) / 2; }
__host__ __device__ __forceinline__ int perm32(int rho) { const int n = rho >> 4, i = rho & 15; return 8 * (i >> 2) + 4 * n + (i & 3); }

struct Unit { int pm, pn, kb, nt, piece; };
struct Gemm { const bf16_t* A; const bf16_t* Bt; int M, N, K; };

struct StaticOrder {
    int nM, nN, nwg, G, c, ntk;
    __host__ __device__ __forceinline__ void init(int M, int N, int G_, int c_, int ntk_) { nM = M / BM; nN = N / BM; nwg = nM * nN; G = G_; c = c_; ntk = ntk_; }
    __host__ __device__ __forceinline__ bool next(int i, Unit& u) const {
        const long L = (long)i * G + c; if (L >= nwg) { u.pm = 0; u.pn = 0; u.kb = 0; u.nt = ntk; u.piece = 0; return false; }
        int wgid = (int)L; { const int q = nwg / NXCD, r = nwg % NXCD, xcd = wgid % NXCD, off = wgid / NXCD; wgid = (xcd < r ? xcd * (q + 1) : r * (q + 1) + (xcd - r) * q) + off; }
        const int nig = WGM * nN, gid = wgid / nig, fm = gid * WGM, gsz = (nM - fm) < WGM ? (nM - fm) : WGM;
        u.pm = fm + ((wgid % nig) % gsz); u.pn = (wgid % nig) / gsz; u.kb = 0; u.nt = ntk; u.piece = 0; return true;
    }
    __device__ __forceinline__ void a_ready(const Unit&) const {}
    __device__ __forceinline__ void done(const Unit&) const {}
};

struct OneUnit {
    int pm, pn, ntk;
    __host__ __device__ __forceinline__ bool next(int i, Unit& u) const { u.pm = pm; u.pn = pn; u.kb = 0; u.nt = ntk; u.piece = 0; return i == 0; }
    __device__ __forceinline__ void a_ready(const Unit&) const {}
    __device__ __forceinline__ void done(const Unit&) const {}
};
struct PieceOrder {
    int pm, nN, np, ntp, c;
    __host__ __device__ __forceinline__ bool next(int i, Unit& u) const { u.pm = pm; u.pn = c % nN; u.piece = c / nN; u.kb = (c / nN) * ntp * BK * 2; u.nt = ntp; return i == 0 && c < nN * np; }
    __device__ __forceinline__ void a_ready(const Unit&) const {}
    __device__ __forceinline__ void done(const Unit&) const {}
};
struct SplitOrder {
    StaticOrder base; int np, ntp;
    __host__ __device__ __forceinline__ void init(int Mp, int N, int G_, int c_, int ntk_, int ntp_) { base.init(Mp, N, G_, c_, ntk_); ntp = ntp_; np = ntk_ / ntp_; }
    __host__ __device__ __forceinline__ bool next(int i, Unit& u) const {
        const long L = (long)i * base.G + base.c; Unit a = {0, 0, 0, 0, 0}; const bool okp = base.next(i, a);
        const int sp = (int)(L - base.nwg), piece = sp / base.nN; const bool oks = !okp && piece < np;
        u.pm = okp ? a.pm : base.nM; u.pn = okp ? a.pn : sp % base.nN; u.kb = okp ? 0 : piece * ntp * BK * 2; u.nt = okp ? base.ntk : (piece == np - 1 ? base.ntk - (np - 1) * ntp : ntp); u.piece = okp ? 0 : piece;
        return okp || oks;
    }
    __device__ __forceinline__ void a_ready(const Unit&) const {}
    __device__ __forceinline__ void done(const Unit&) const {}
};
__device__ __forceinline__ unsigned cvt_pk_bf16(float lo, float hi) { unsigned r; asm volatile("v_cvt_pk_bf16_f32 %0, %1, %2" : "=v"(r) : "v"(lo), "v"(hi)); return r; }
typedef float f32x2 __attribute__((ext_vector_type(2)));
constexpr int EP_MODW = 9216;
__device__ __forceinline__ int ep_batch(int pm, int ai, int wr, int m) { return pm < 128 ? (pm >> 5) : (4 + 8 * ai + 4 * wr + m); }
__device__ __forceinline__ float ep_silu(float x) { return x * __builtin_amdgcn_rcpf(1.0f + __builtin_amdgcn_exp2f(-1.4426950408889634f * x)); }
__device__ __forceinline__ float ep_sigmoid(float x) { return __builtin_amdgcn_rcpf(1.0f + __builtin_amdgcn_exp2f(-1.4426950408889634f * x)); }

struct EpiSwiGLU {
    static constexpr bool PERM = true, AFTER_DRAIN = false;
    unsigned char* O; float s;
    __device__ __forceinline__ void operator()(f32x4 (&acc)[2][2][4][2], const Unit& u, int wr, int wc, int fr_, int fq_) const {
        int fr = fr_, fq = fq_; asm volatile("" : "+v"(fr), "+v"(fq));
        const int row0 = u.pm * BM + wr * 64 + fr, col0 = u.pn * 128 + wc * 32 + 8 * fq;
#pragma unroll
        for (int ai = 0; ai < 2; ++ai)
#pragma unroll
            for (int m = 0; m < 4; ++m) { unsigned char* rowp = O + (size_t)(row0 + ai * HALF + m * 16) * 2816 + col0;
                typedef float f32x2_t __attribute__((ext_vector_type(2)));
                const float c1 = -1.4426950408889634f * s, is2 = 1.0f / (s * s);
                f32x2_t h2[4];
#pragma unroll
                for (int n = 0; n < 2; ++n)
#pragma unroll
                    for (int i = 0; i < 4; i += 2) { const f32x2_t a = {acc[ai][0][m][n][i], acc[ai][0][m][n][i + 1]}, b = {acc[ai][1][m][n][i], acc[ai][1][m][n][i + 1]};
                        f32x2_t e = a * c1; e.x = __builtin_amdgcn_exp2f(e.x); e.y = __builtin_amdgcn_exp2f(e.y);
                        f32x2_t d = e * is2 + is2; d.x = __builtin_amdgcn_rcpf(d.x); d.y = __builtin_amdgcn_rcpf(d.y);
                        h2[2 * n + (i >> 1)] = (a * b) * d; }
                int w0 = __builtin_bit_cast(int, h2[0].x), w1 = __builtin_bit_cast(int, h2[2].x);
                w0 = __builtin_amdgcn_cvt_pk_fp8_f32(h2[0].x, h2[0].y, w0, false); w0 = __builtin_amdgcn_cvt_pk_fp8_f32(h2[1].x, h2[1].y, w0, true); w1 = __builtin_amdgcn_cvt_pk_fp8_f32(h2[2].x, h2[2].y, w1, false); w1 = __builtin_amdgcn_cvt_pk_fp8_f32(h2[3].x, h2[3].y, w1, true);
                typedef unsigned u32x2_t __attribute__((ext_vector_type(2))); *(u32x2_t*)rowp = (u32x2_t){(unsigned)w0, (unsigned)w1}; }
    }
};
__device__ __forceinline__ f32x4 ep_bf_lo(unsigned a, unsigned b) { f32x4 r; r[0] = __builtin_bit_cast(float, a << 16); r[1] = __builtin_bit_cast(float, a & 0xffff0000u); r[2] = __builtin_bit_cast(float, b << 16); r[3] = __builtin_bit_cast(float, b & 0xffff0000u); return r; }
template <bool BASE_BF16> struct EpiResid {
    static constexpr bool PERM = true, AFTER_DRAIN = false;
    const void* base_p; bf16_t* out; const float* gate; float coef; float* part;
    __device__ __forceinline__ void operator()(f32x4 (&acc)[2][2][4][2], const Unit& u, int wr, int wc, int fr_, int fq_) const {
        int fr = fr_, fq = fq_; asm volatile("" : "+v"(fr), "+v"(fq));
        const unsigned coff = (unsigned)(u.pn * BM + wc * 32 + 8 * fq), off0 = (unsigned)((wr * 64 + fr) * 1024) + coff;
        if (u.pm >= 128) {
            float* o = part + (size_t)u.piece * BM * 1024;
#pragma unroll
            for (int ai = 0; ai < 2; ++ai)
#pragma unroll
                for (int m = 0; m < 4; ++m) { const unsigned offr = off0 + (unsigned)((ai * HALF + m * 16) * 1024); const float* g = gate + (size_t)ep_batch(u.pm, ai, wr, m) * EP_MODW;
#pragma unroll
                    for (int bj = 0; bj < 2; ++bj)
#pragma unroll
                        for (int n = 0; n < 2; ++n) { const unsigned c = (unsigned)(bj * HALF + n * 4); *(f32x4*)(o + (offr + c)) = (*(const f32x4*)(g + (coff + c)) * coef) * acc[ai][bj][m][n]; } }
            return;
        }
        const char* base = (const char*)base_p + (size_t)u.pm * BM * 1024 * (BASE_BF16 ? 2 : 4); char* o = (char*)(out + (size_t)u.pm * BM * 1024); const char* g = (const char*)(gate + (size_t)(u.pm >> 5) * EP_MODW);
        const unsigned vb = off0 * (BASE_BF16 ? 2u : 4u), vo = off0 * 2u, vc = coff * 4u;
        f32x4 bs[2][2][2];
        u32x4 bb[2][2];
#define ER_LOADQ(q_) do { _Pragma("unroll") for (int mm = 0; mm < 2; ++mm) _Pragma("unroll") for (int bj = 0; bj < 2; ++bj) { const int ro_ = (((q_) >> 1) * HALF + (((q_) & 1) * 2 + mm) * 16) * 1024 + bj * HALF; \
            if (BASE_BF16) bb[mm][bj] = *(const u32x4*)(base + ro_ * 2 + vb); else { bs[mm][bj][0] = __builtin_nontemporal_load((const f32x4*)(base + ro_ * 4 + vb)); bs[mm][bj][1] = __builtin_nontemporal_load((const f32x4*)(base + (ro_ + 4) * 4 + vb)); } } } while (0)
        {
            f32x4 gv[2][2];
#pragma unroll
            for (int bj = 0; bj < 2; ++bj)
#pragma unroll
                for (int n = 0; n < 2; ++n) gv[bj][n] = *(const f32x4*)(g + (bj * HALF + n * 4) * 4 + vc);
            ER_LOADQ(0);
            asm volatile("" ::: "memory");
#pragma unroll
            for (int ai = 0; ai < 2; ++ai)
#pragma unroll
                for (int m = 0; m < 4; ++m)
#pragma unroll
                    for (int bj = 0; bj < 2; ++bj)
#pragma unroll
                        for (int n = 0; n < 2; ++n) acc[ai][bj][m][n] = (gv[bj][n] * coef) * acc[ai][bj][m][n];
        }
#pragma unroll
        for (int q = 0; q < 4; ++q) {
            const int ai = q >> 1, m0 = (q & 1) * 2;
            u32x4 ow[2][2];
#pragma unroll
            for (int mm = 0; mm < 2; ++mm)
#pragma unroll
                for (int bj = 0; bj < 2; ++bj) { f32x4 x0, x1;
                    if (BASE_BF16) { x0 = acc[ai][bj][m0 + mm][0] + ep_bf_lo(bb[mm][bj][0], bb[mm][bj][1]); x1 = acc[ai][bj][m0 + mm][1] + ep_bf_lo(bb[mm][bj][2], bb[mm][bj][3]); }
                    else { x0 = acc[ai][bj][m0 + mm][0] + bs[mm][bj][0]; x1 = acc[ai][bj][m0 + mm][1] + bs[mm][bj][1]; }
                    ow[mm][bj][0] = cvt_pk_bf16(x0[0], x0[1]); ow[mm][bj][1] = cvt_pk_bf16(x0[2], x0[3]); ow[mm][bj][2] = cvt_pk_bf16(x1[0], x1[1]); ow[mm][bj][3] = cvt_pk_bf16(x1[2], x1[3]); }
            asm volatile("" ::: "memory");
            if (q < 3) ER_LOADQ(q + 1);
            asm volatile("" ::: "memory");
#pragma unroll
            for (int mm = 0; mm < 2; ++mm)
#pragma unroll
                for (int bj = 0; bj < 2; ++bj) *(u32x4*)(o + ((ai * HALF + (m0 + mm) * 16) * 1024 + bj * HALF) * 2 + vo) = ow[mm][bj];
            asm volatile("" ::: "memory");
        }
#undef ER_LOADQ
    }
};
struct EpiPart {
    static constexpr bool PERM = true, AFTER_DRAIN = false;
    float* P; int ld;
    __device__ __forceinline__ void operator()(f32x4 (&acc)[2][2][4][2], const Unit& u, int wr, int wc, int fr_, int fq_) const {
        int fr = fr_, fq = fq_; asm volatile("" : "+v"(fr), "+v"(fq));
        float* o = P + (size_t)u.piece * BM * ld + (size_t)(wr * 64 + fr) * ld + u.pn * BM + wc * 32 + 8 * fq;
#pragma unroll
        for (int ai = 0; ai < 2; ++ai)
#pragma unroll
            for (int m = 0; m < 4; ++m)
#pragma unroll
                for (int bj = 0; bj < 2; ++bj)
#pragma unroll
                    for (int n = 0; n < 2; ++n) *(f32x4*)(o + (size_t)(ai * HALF + m * 16) * ld + bj * HALF + n * 4) = acc[ai][bj][m][n];
    }
};
struct EpiIn {
    static constexpr bool PERM = true, AFTER_DRAIN = false;
    bf16_t *A2, *KB, *VB, *UB; float* dout; const float *gq, *gk; float c2;
    size_t o_kp, o_vp, o_ks, o_vs, o_cp, o_cs; int probe;
    __device__ __forceinline__ void operator()(f32x4 (&acc)[2][2][4][2], const Unit& u, int wr, int wc, int fr_, int fq_) const {
        int fr = fr_, fq = fq_; asm volatile("" : "+v"(fr), "+v"(fq));
        if (probe == 3) { if (acc[0][0][0][0][0] == 12345.678f) dout[fr] = acc[1][1][3][1][3]; return; }
        const int pn = u.pn; const bool smp = u.pm >= 128;
        const size_t trow = (size_t)u.pm * BM, srow = smp ? 0 : trow;
        const unsigned rl0 = (unsigned)(wr * 64 + fr);
        if (pn < 6) {
            const int sec = pn >> 1, head = 4 * (pn & 1) + wc;
            if (sec < 2) {
                f32x4 g[2][2];
#pragma unroll
                for (int bj = 0; bj < 2; ++bj)
#pragma unroll
                    for (int n = 0; n < 2; ++n) g[bj][n] = *(const f32x4*)((sec == 0 ? gq : gk) + 32 * bj + 8 * fq + 4 * n) * (sec == 0 ? c2 : 1.0f);
                asm volatile("s_waitcnt vmcnt(0)" : "+v"(g[0][0]), "+v"(g[0][1]), "+v"(g[1][0]), "+v"(g[1][1]) :: "memory");
#pragma unroll
                for (int ai = 0; ai < 2; ++ai)
#pragma unroll
                    for (int m = 0; m < 4; ++m) { float ss = 0.f;
#pragma unroll
                        for (int bj = 0; bj < 2; ++bj)
#pragma unroll
                            for (int n = 0; n < 2; ++n) { const f32x4 v = acc[ai][bj][m][n]; ss += (v[0] * v[0] + v[1] * v[1]) + (v[2] * v[2] + v[3] * v[3]); }
                        ss = xsum32(xsum16(ss));
                        const float r = __builtin_amdgcn_rsqf(ss * (1.0f / 64.0f) + 1e-6f);
#pragma unroll
                        for (int bj = 0; bj < 2; ++bj)
#pragma unroll
                            for (int n = 0; n < 2; ++n) acc[ai][bj][m][n] = acc[ai][bj][m][n] * r * g[bj][n]; }
            }
            const size_t kvd = (size_t)(VB - KB), sel = (size_t)(sec == 2 ? 1 : 0);
            bf16_t* db = (sec == 0 ? A2 + trow * 1024 : KB + sel * kvd + trow * 512) + head * 64 + 8 * fq;
            const unsigned pitch = sec == 0 ? 1024u : 512u;
            float* df = dout + (smp ? o_ks + sel * (o_vs - o_ks) : o_kp + sel * (o_vp - o_kp)) + srow * 512 + head * 64 + 8 * fq;
#pragma unroll
            for (int ai = 0; ai < 2; ++ai)
#pragma unroll
                for (int m = 0; m < 4; ++m) { const unsigned rl = rl0 + (unsigned)(ai * HALF + m * 16);
#pragma unroll
                    for (int bj = 0; bj < 2; ++bj) { const f32x4 a = acc[ai][bj][m][0], b = acc[ai][bj][m][1]; u32x4 w; w.x = cvt_pk_bf16(a[0], a[1]); w.y = cvt_pk_bf16(a[2], a[3]); w.z = cvt_pk_bf16(b[0], b[1]); w.w = cvt_pk_bf16(b[2], b[3]);
                        if (probe < 2) *(u32x4*)(db + (rl * pitch + (unsigned)(32 * bj))) = w;
                        if (sec != 0 && probe < 1) { __builtin_nontemporal_store(a, (f32x4*)(df + (rl * 512u + (unsigned)(32 * bj)))); __builtin_nontemporal_store(b, (f32x4*)(df + (rl * 512u + (unsigned)(32 * bj + 4)))); } } }
        } else {
            const int c0 = 128 * (pn - 6) + wc * 32 + 8 * fq;
            bf16_t* ub = UB + trow * 512 + c0;
            const bool tail = !smp && (u.pm & 31) == 31;
#pragma unroll
            for (int ai = 0; ai < 2; ++ai)
#pragma unroll
                for (int m = 0; m < 4; ++m) { const unsigned rl = rl0 + (unsigned)(ai * HALF + m * 16);
                    f32x4 uu[2];
#pragma unroll
                    for (int n = 0; n < 2; ++n)
#pragma unroll
                        for (int i = 0; i < 4; ++i) uu[n][i] = acc[ai][0][m][n][i] * ep_sigmoid(acc[ai][1][m][n][i]);
                    u32x4 w; w.x = cvt_pk_bf16(uu[0][0], uu[0][1]); w.y = cvt_pk_bf16(uu[0][2], uu[0][3]); w.z = cvt_pk_bf16(uu[1][0], uu[1][1]); w.w = cvt_pk_bf16(uu[1][2], uu[1][3]);
                    if (probe < 2) *(u32x4*)(ub + rl * 512u) = w;
                    if (smp) { float* d = dout + o_cs + ((size_t)(rl >> 4) * 30 + 14 + (rl & 15)) * 512 + c0; *(f32x4*)d = uu[0]; *(f32x4*)(d + 4) = uu[1]; }
                    else if (tail && ai == 1 && m >= 2) { if (rl >= 226u) { float* d = dout + o_cp + ((size_t)(u.pm >> 5) * 30 + (rl - 226u)) * 512 + c0; *(f32x4*)d = uu[0]; *(f32x4*)(d + 4) = uu[1]; } } }
        }
    }
};

#if defined(PROBE_NULLEPI) || defined(PROBE_NULLIN)
struct EpiNull {
    static constexpr bool PERM = true, AFTER_DRAIN = false;
    float* O;
    __device__ __forceinline__ void operator()(f32x4 (&acc)[2][2][4][2], const Unit& u, int wr, int wc, int fr_, int fq_) const {
        int fr = fr_, fq = fq_; asm volatile("" : "+v"(fr), "+v"(fq));
        f32x4 s = (f32x4){0.f, 0.f, 0.f, 0.f};
#pragma unroll
        for (int ai = 0; ai < 2; ++ai)
#pragma unroll
            for (int bj = 0; bj < 2; ++bj)
#pragma unroll
                for (int m = 0; m < 4; ++m)
#pragma unroll
                    for (int n = 0; n < 2; ++n) s += acc[ai][bj][m][n];
        if (s[0] + s[1] + s[2] + s[3] == 12345.678f) O[u.pm * 256 + wr * 64 + fr] = s[0];
    }
};
#endif
typedef int v4i_t __attribute__((ext_vector_type(4))); typedef int v8i_t __attribute__((ext_vector_type(8)));
__device__ __forceinline__ v8i_t cat8(bf16x8 lo, bf16x8 hi) { return __builtin_shufflevector(__builtin_bit_cast(v4i_t, lo), __builtin_bit_cast(v4i_t, hi), 0, 1, 2, 3, 4, 5, 6, 7); }
__device__ __forceinline__ void glds_sv(const void* sbase_, unsigned voff, unsigned ldsaddr) { unsigned keep;
    const unsigned long long sb_ = (unsigned long long)(uintptr_t)sbase_;
    const void* sbase = (const void*)(uintptr_t)(((unsigned long long)(unsigned)__builtin_amdgcn_readfirstlane((int)(sb_ >> 32)) << 32) | (unsigned)__builtin_amdgcn_readfirstlane((int)(unsigned)sb_));
    asm volatile("s_mov_b32 %0, m0\n\ts_mov_b32 m0, %3\n\ts_nop 0\n\tglobal_load_lds_dwordx4 %1, %2\n\ts_mov_b32 m0, %0" : "=&s"(keep) : "v"(voff), "s"(sbase), "s"(ldsaddr) : "memory"); }
template <class Epi, class Sched, bool ALIGN_EPI = false, bool SP2 = false, bool FP8 = false>
__device__ __forceinline__ void gemm_phase(PG8_LAS unsigned char* lds, const Gemm g, const Sched& S, const Epi& E) {
    const int tid = threadIdx.x, wid = __builtin_amdgcn_readfirstlane(tid >> 6), lane = tid & 63, wr = wid >> 2, wc = wid & 3, fr = lane & 15, fq = lane >> 4;
    const int K = g.K; constexpr int ES = FP8 ? 1 : 2;
    unsigned voffA[2], voffB[2];
#pragma unroll
    for (int i = 0; i < 2; ++i) { int R, C; stage_rc(tid * 16 + i * 8192, R, C); const int Rb = Epi::PERM ? ((R & ~31) + perm32(R & 31)) : R;
        voffA[i] = (unsigned)(R * K * ES + C * 2); voffB[i] = (unsigned)(Rb * K * ES + C * 2); }
    const size_t kstep = (size_t)(BK * 2);
    const size_t hstep = (size_t)HALF * K * ES;
    const size_t tstep = 2 * hstep;
    const unsigned ldsw = (unsigned)wid * 1024u, ldsb = (unsigned)(uintptr_t)lds;
    const int aoff = lds_byte(wr * 64 + fr, fq * 8), boff = lds_byte(wc * 32 + fr, fq * 8);
#define PG8_SA(b, h) (((b) * 2 + (h)) * HTB)
#define PG8_SB(b, h) ((4 + (b) * 2 + (h)) * HTB)
#define PG8_STAGE(bufoff, gbase, voff) do { _Pragma("unroll") for (int _i = 0; _i < 2; ++_i) glds_sv((gbase), (voff)[_i], ldsb + (unsigned)(bufoff) + ldsw + _i * 8192u); } while (0)
#define PG8_LDA(dst, b, h) do { _Pragma("unroll") for (int m = 0; m < 4; ++m) dst[m] = cat8(*(const PG8_LAS bf16x8*)(lds + PG8_SA(b, h) + aoff + m * 2048), *(const PG8_LAS bf16x8*)(lds + PG8_SA(b, h) + aoff + m * 2048 + 1024)); } while (0)
#define PG8_LDB(dst, b, h) do { _Pragma("unroll") for (int n = 0; n < 2; ++n) dst[n] = cat8(*(const PG8_LAS bf16x8*)(lds + PG8_SB(b, h) + boff + n * 2048), *(const PG8_LAS bf16x8*)(lds + PG8_SB(b, h) + boff + n * 2048 + 1024)); } while (0)
#define PG8_HALF(x, k) __builtin_bit_cast(bf16x8, (k) == 0 ? __builtin_shufflevector(x, x, 0, 1, 2, 3) : __builtin_shufflevector(x, x, 4, 5, 6, 7))
#define PG8_MMA(ai, bj, At, Bt) do { __builtin_amdgcn_s_setprio(1); _Pragma("unroll") for (int m = 0; m < 4; ++m) _Pragma("unroll") for (int n = 0; n < 2; ++n) { \
        if constexpr (FP8) { acc[ai][bj][m][n] = __builtin_amdgcn_mfma_scale_f32_16x16x128_f8f6f4(Bt[n], At[m], acc[ai][bj][m][n], 0, 0, 0, 0, 0, 0); }     \
        else { _Pragma("unroll") for (int k = 0; k < 2; ++k) acc[ai][bj][m][n] = __builtin_amdgcn_mfma_f32_16x16x32_bf16(PG8_HALF(Bt[n], k), PG8_HALF(At[m], k), acc[ai][bj][m][n], 0, 0, 0); } } __builtin_amdgcn_s_setprio(0); } while (0)
#define PG8_UNI(u_) do { (u_).pm = __builtin_amdgcn_readfirstlane((u_).pm); (u_).pn = __builtin_amdgcn_readfirstlane((u_).pn); (u_).kb = __builtin_amdgcn_readfirstlane((u_).kb); (u_).nt = __builtin_amdgcn_readfirstlane((u_).nt); (u_).piece = __builtin_amdgcn_readfirstlane((u_).piece); } while (0)
#define PG8_WAIT_V(n) asm volatile("s_waitcnt vmcnt(" #n ")" ::: "memory")
#define PG8_WAIT_L(n) asm volatile("s_waitcnt lgkmcnt(" #n ")" ::: "memory")
#define PG8_BAR __builtin_amdgcn_s_barrier()
#define PG8_SCHED __builtin_amdgcn_sched_barrier(0)
    Unit cur = {0, 0, 0, 0, 0}, nxt = {0, 0, 0, 0, 0}; int ui = 0;
    if (!S.next(0, cur)) return;
    PG8_UNI(cur);
    f32x4 acc[2][2][4][2];
#pragma unroll
    for (int a = 0; a < 2; ++a)
#pragma unroll
        for (int b = 0; b < 2; ++b)
#pragma unroll
            for (int m = 0; m < 4; ++m)
#pragma unroll
                for (int n = 0; n < 2; ++n) acc[a][b][m][n] = (f32x4){0.f, 0.f, 0.f, 0.f};
    v8i_t At[4], B0[2], B1[2];
    const char* cA = (const char*)g.A + (size_t)cur.pm * tstep + cur.kb; const char* cB = (const char*)g.Bt + (size_t)cur.pn * tstep + cur.kb;
    S.a_ready(cur);
    if constexpr (SP2) {
        PG8_STAGE(PG8_SB(0, 0), cB, voffB); PG8_STAGE(PG8_SB(0, 1), cB + hstep, voffB); PG8_STAGE(PG8_SA(0, 0), cA, voffA); PG8_STAGE(PG8_SA(0, 1), cA + hstep, voffA);
        if (wr == 1) PG8_BAR;
        PG8_WAIT_V(2); PG8_BAR;
        PG8_STAGE(PG8_SB(1, 0), cB + kstep, voffB); PG8_STAGE(PG8_SA(1, 0), cA + kstep, voffA); PG8_STAGE(PG8_SB(1, 1), cB + hstep + kstep, voffB);
        PG8_WAIT_V(6); PG8_BAR;
    } else {
        PG8_STAGE(PG8_SB(0, 0), cB, voffB); PG8_STAGE(PG8_SA(0, 0), cA, voffA); PG8_STAGE(PG8_SB(0, 1), cB + hstep, voffB); PG8_STAGE(PG8_SA(0, 1), cA + hstep, voffA);
        if (wr == 1) PG8_BAR;
        PG8_WAIT_V(4); PG8_BAR;
        PG8_STAGE(PG8_SB(1, 0), cB + kstep, voffB); PG8_STAGE(PG8_SA(1, 0), cA + kstep, voffA); PG8_STAGE(PG8_SB(1, 1), cB + hstep + kstep, voffB);
        PG8_WAIT_V(6); PG8_BAR;
    }
    for (;;) {
        const bool has_next = __builtin_amdgcn_readfirstlane((int)S.next(ui + 1, nxt)) != 0; PG8_UNI(nxt);
        const char* nA = has_next ? (const char*)g.A + (size_t)nxt.pm * tstep + nxt.kb : cA; const char* nB = has_next ? (const char*)g.Bt + (size_t)nxt.pn * tstep + nxt.kb : cB;
        const int nt = cur.nt;
        for (int t = 0; t < nt; t += 2) {
            const bool last = (t == nt - 2);
            const char* a1 = cA + (size_t)(t + 1) * kstep;
            const char* a2 = last ? nA : cA + (size_t)(t + 2) * kstep; const char* b2 = last ? nB : cB + (size_t)(t + 2) * kstep;
            const char* a3 = a2 + kstep; const char* b3 = b2 + kstep;
            if (last && has_next) S.a_ready(nxt);
            if constexpr (SP2) {
            PG8_LDB(B0, 0, 0); PG8_LDB(B1, 0, 1); PG8_SCHED; PG8_LDA(At, 0, 0); PG8_STAGE(PG8_SA(1, 1), a1 + hstep, voffA);
            PG8_WAIT_V(8); PG8_WAIT_L(0); PG8_BAR; PG8_MMA(0, 0, At, B0); PG8_MMA(0, 1, At, B1); PG8_BAR; PG8_SCHED;
            PG8_LDA(At, 0, 1); PG8_STAGE(PG8_SB(0, 0), b2, voffB); PG8_STAGE(PG8_SB(0, 1), b2 + hstep, voffB); PG8_STAGE(PG8_SA(0, 0), a2, voffA);
            PG8_WAIT_V(8); PG8_WAIT_L(0); PG8_BAR; PG8_MMA(1, 0, At, B0); PG8_MMA(1, 1, At, B1); PG8_BAR; PG8_SCHED;
            PG8_LDB(B0, 1, 0); PG8_LDB(B1, 1, 1); PG8_SCHED; PG8_LDA(At, 1, 0); PG8_STAGE(PG8_SA(0, 1), a2 + hstep, voffA);
            PG8_WAIT_V(8); PG8_WAIT_L(0); PG8_BAR; PG8_MMA(0, 0, At, B0); PG8_MMA(0, 1, At, B1); PG8_BAR; PG8_SCHED;
            PG8_LDA(At, 1, 1); PG8_STAGE(PG8_SB(1, 0), b3, voffB); PG8_STAGE(PG8_SB(1, 1), b3 + hstep, voffB); PG8_STAGE(PG8_SA(1, 0), a3, voffA);
            PG8_WAIT_V(8); PG8_WAIT_L(0); PG8_BAR; PG8_MMA(1, 0, At, B0); PG8_MMA(1, 1, At, B1); PG8_BAR; PG8_SCHED;
            } else {
            PG8_LDB(B0, 0, 0); PG8_SCHED; PG8_LDA(At, 0, 0); PG8_STAGE(PG8_SA(1, 1), a1 + hstep, voffA);
            PG8_WAIT_L(8); PG8_BAR; PG8_WAIT_L(0); PG8_MMA(0, 0, At, B0); PG8_BAR; PG8_SCHED;
            PG8_LDB(B1, 0, 1); PG8_STAGE(PG8_SB(0, 0), b2, voffB);
            PG8_BAR; PG8_WAIT_L(0); PG8_MMA(0, 1, At, B1); PG8_BAR;
            PG8_LDA(At, 0, 1); PG8_STAGE(PG8_SA(0, 0), a2, voffA);
            PG8_BAR; PG8_WAIT_L(0); PG8_MMA(1, 0, At, B0); PG8_BAR; PG8_SCHED;
            PG8_STAGE(PG8_SB(0, 1), b2 + hstep, voffB);
            PG8_WAIT_V(6); PG8_BAR; PG8_MMA(1, 1, At, B1); PG8_BAR;
            PG8_LDB(B0, 1, 0); PG8_SCHED; PG8_LDA(At, 1, 0); PG8_STAGE(PG8_SA(0, 1), a2 + hstep, voffA);
            PG8_WAIT_L(8); PG8_BAR; PG8_WAIT_L(0); PG8_MMA(0, 0, At, B0); PG8_BAR; PG8_SCHED;
            PG8_LDB(B1, 1, 1); PG8_STAGE(PG8_SB(1, 0), b3, voffB);
            PG8_BAR; PG8_WAIT_L(0); PG8_MMA(0, 1, At, B1); PG8_BAR;
            PG8_LDA(At, 1, 1); PG8_STAGE(PG8_SA(1, 0), a3, voffA);
            PG8_BAR; PG8_WAIT_L(0); PG8_MMA(1, 0, At, B0); PG8_BAR; PG8_SCHED;
            PG8_STAGE(PG8_SB(1, 1), b3 + hstep, voffB);
            PG8_WAIT_V(6); PG8_BAR; PG8_MMA(1, 1, At, B1); PG8_BAR;
            }
        }
        if constexpr (ALIGN_EPI) { if (wr == 0) PG8_BAR; }
        if constexpr (!Epi::AFTER_DRAIN) { E(acc, cur, wr, wc, fr, fq); S.done(cur); }
        if (!has_next) break;
#pragma unroll
        for (int a = 0; a < 2; ++a)
#pragma unroll
            for (int b = 0; b < 2; ++b)
#pragma unroll
                for (int m = 0; m < 4; ++m)
#pragma unroll
                    for (int n = 0; n < 2; ++n) acc[a][b][m][n] = (f32x4){0.f, 0.f, 0.f, 0.f};
        cur = nxt; cA = nA; cB = nB; ++ui;
        if constexpr (ALIGN_EPI) { if (wr == 1) PG8_BAR; }
    }
    PG8_WAIT_V(0);
    if constexpr (!ALIGN_EPI) { if (wr == 0) PG8_BAR; }
    PG8_BAR;
    if constexpr (Epi::AFTER_DRAIN) { E.fused(acc, cur, wr, wc, fr, fq, lds, wid, lane); S.done(cur); }
#undef PG8_SA
#undef PG8_SB
#undef PG8_STAGE
#undef PG8_LDA
#undef PG8_LDB
#undef PG8_HALF
#undef PG8_MMA
#undef PG8_UNI
#undef PG8_WAIT_V
#undef PG8_WAIT_L
#undef PG8_BAR
#undef PG8_SCHED
}
}
#include <hip/hip_bf16.h>
namespace attn_body {
using bf16=__hip_bfloat16;
using bf16x8=__attribute__((ext_vector_type(8)))short;
using s16x4=__attribute__((ext_vector_type(4)))short;
using f32x16=__attribute__((ext_vector_type(16)))float;
using u32x4=__attribute__((ext_vector_type(4)))unsigned;
constexpr int BATCH=4,NHEAD=8,SEQ=8192,D=64,DMQ=1024,DMK=512;
constexpr int NW=8,QBLK=32,QB=QBLK*NW,KVBLK=64,NQB=SEQ/QB;
constexpr int ATTN_UNIT_ROWS=QB;
__device__ __forceinline__ int crow(int r,int hi){return (r&3)+8*(r>>2)+4*hi;}
#define SBAR() __builtin_amdgcn_sched_barrier(0)
__device__ __forceinline__ void cmask(f32x16&p0,f32x16&p1,int jb,int qrel,int hi){
  const float NEG=-INFINITY; int lim=qrel-(64*jb+4*hi); asm volatile("":"+v"(lim));
  #pragma unroll
  for(int r=0;r<16;++r){const int c=(r&3)+8*(r>>2); if(c>lim)p0[r]=NEG; if(c+32>lim)p1[r]=NEG;}
}

constexpr int NSLOT=3, SLOTB=8192;
constexpr int LDS_K=0, LDS_V=NSLOT*SLOTB, LDS_WS=2*NSLOT*SLOTB, LDS_OST=LDS_WS+NW*64*4, LDS_BYTES=LDS_OST+NW*4096, LDS_FSB=LDS_BYTES, LDS_TOTAL=LDS_FSB+SEQ*4;
constexpr float C2=0.125f*1.4426950408889634f;
__device__ __forceinline__ void glds16(const void*gsrc,unsigned lds_dst){unsigned keep;
  asm volatile("s_mov_b32 %0, m0\n\ts_mov_b32 m0, %2\n\ts_nop 0\n\tglobal_load_lds_dwordx4 %1, off\n\ts_mov_b32 m0, %0":"=&s"(keep):"v"(gsrc),"s"(lds_dst):"memory");}
__device__ __forceinline__ float max3f(float a,float b,float c){float r;asm("v_max3_f32 %0, %1, %2, %3":"=v"(r):"v"(a),"v"(b),"v"(c));return r;}
__device__ __forceinline__ float max2f(float a,float b){float r;asm("v_max_f32_e32 %0, %1, %2":"=v"(r):"v"(a),"v"(b));return r;}
__device__ __forceinline__ float fadd_s(float a,float b){float r;asm("v_add_f32_e32 %0, %1, %2":"=v"(r):"v"(a),"v"(b));return r;}
__device__ __forceinline__ float fsub_s(float a,float b){float r;asm("v_sub_f32_e32 %0, %1, %2":"=v"(r):"v"(a),"v"(b));return r;}
typedef float f32x2_t __attribute__((ext_vector_type(2))); typedef __bf16 bf16x2_t __attribute__((ext_vector_type(2)));
__device__ __forceinline__ unsigned cvtpk_s(float lo,float hi){f32x2_t v={lo,hi};bf16x2_t b=__builtin_convertvector(v,bf16x2_t);return __builtin_bit_cast(unsigned,b);}
#define WAIT_BAR(N) asm volatile("s_waitcnt vmcnt(" #N ") lgkmcnt(0)\n\ts_barrier":::"memory")

__device__ __forceinline__ void qkt(f32x16&p0,f32x16&p1,const char*Kslot,const bf16x8*qr,int r32,int hi){
  const char*kb=Kslot+hi*1024+r32*16;
  #pragma unroll
  for(int d0=0;d0<4;++d0){
    const bf16x8 b0=*reinterpret_cast<const bf16x8*>(kb+d0*2048);
    const bf16x8 b1=*reinterpret_cast<const bf16x8*>(kb+d0*2048+512);
    p0=__builtin_amdgcn_mfma_f32_32x32x16_bf16(b0,qr[d0],p0,0,0,0);p1=__builtin_amdgcn_mfma_f32_32x32x16_bf16(b1,qr[d0],p1,0,0,0);}
}
typedef __attribute__((address_space(3))) const char* lds_cptr;
typedef short v4i16_t __attribute__((ext_vector_type(4)));
__device__ __forceinline__ void kload8(bf16x8*kf,lds_cptr kp){
  kf[0]=*(const __attribute__((address_space(3))) bf16x8*)(kp);      kf[1]=*(const __attribute__((address_space(3))) bf16x8*)(kp+512);
  kf[2]=*(const __attribute__((address_space(3))) bf16x8*)(kp+2048); kf[3]=*(const __attribute__((address_space(3))) bf16x8*)(kp+2560);
  kf[4]=*(const __attribute__((address_space(3))) bf16x8*)(kp+4096); kf[5]=*(const __attribute__((address_space(3))) bf16x8*)(kp+4608);
  kf[6]=*(const __attribute__((address_space(3))) bf16x8*)(kp+6144); kf[7]=*(const __attribute__((address_space(3))) bf16x8*)(kp+6656);
}
__device__ __forceinline__ void kload2(bf16x8*kf,lds_cptr kp,int j){ kf[2*j]=*(const __attribute__((address_space(3))) bf16x8*)(kp+j*2048); kf[2*j+1]=*(const __attribute__((address_space(3))) bf16x8*)(kp+j*2048+512); }
__device__ __forceinline__ s16x4 vtr(lds_cptr p){ return __builtin_bit_cast(s16x4,__builtin_amdgcn_ds_read_tr16_b64_v4i16((__attribute__((address_space(3))) v4i16_t*)p)); }
__device__ __forceinline__ float rowmax(const f32x16&p0,const f32x16&p1){
  float a=max3f(p0[0],p0[1],p1[0]),b=max3f(p0[2],p0[3],p1[1]);a=max3f(a,p1[2],p1[3]);
  #pragma unroll
  for(int r=4;r<16;r+=4){a=max3f(a,p0[r],p0[r+1]);b=max3f(b,p0[r+2],p0[r+3]);a=max3f(a,p1[r],p1[r+1]);b=max3f(b,p1[r+2],p1[r+3]);}
  const float m=max2f(a,b);
  auto rr=__builtin_amdgcn_permlane32_swap(__float_as_uint(m),__float_as_uint(m),false,false);
  return max2f(__uint_as_float(rr[0]),__uint_as_float(rr[1]));
}
__device__ __forceinline__ void pv(f32x16*o,int vb,bf16x8 pa0,bf16x8 pa1,bf16x8 pa2,bf16x8 pa3){
  #pragma unroll
  for(int d0=0;d0<2;++d0){s16x4 lo[4],hi[4];
    #pragma unroll
    for(int ks=0;ks<4;++ks){
      asm volatile("ds_read_b64_tr_b16 %0,%1 offset:%c2":"=&v"(lo[ks]):"v"(vb),"i"(d0*4096+ks*1024):"memory");
      asm volatile("ds_read_b64_tr_b16 %0,%1 offset:%c2":"=&v"(hi[ks]):"v"(vb),"i"(d0*4096+ks*1024+512):"memory");}
    asm volatile("s_waitcnt lgkmcnt(0)":::"memory");SBAR();
    #define PK(k) (bf16x8){lo[k][0],lo[k][1],lo[k][2],lo[k][3],hi[k][0],hi[k][1],hi[k][2],hi[k][3]}
    o[d0]=__builtin_amdgcn_mfma_f32_32x32x16_bf16(pa0,PK(0),o[d0],0,0,0);
    o[d0]=__builtin_amdgcn_mfma_f32_32x32x16_bf16(pa1,PK(1),o[d0],0,0,0);
    o[d0]=__builtin_amdgcn_mfma_f32_32x32x16_bf16(pa2,PK(2),o[d0],0,0,0);
    o[d0]=__builtin_amdgcn_mfma_f32_32x32x16_bf16(pa3,PK(3),o[d0],0,0,0);
    #undef PK
  }
}

#ifndef ATTN_STORE16
#define ATTN_STORE16(p,v) (*(u32x4*)(p)=(v))
#endif
template<int THRL,bool FAST> __device__ __forceinline__ void attn_unit(int b,int h,int qb,const bf16*Q,const bf16*__restrict__ K,const bf16*__restrict__ V,bf16*O,const float*__restrict__ Fp,const int*__restrict__ j0tab,float qmaxv,char*shm){
  const int tid=threadIdx.x,lane=tid&63,r32=lane&31,hi=lane>>5; const int wid=__builtin_amdgcn_readfirstlane(tid>>6);
  const long rowbase=(long)b*SEQ; const int q0=qb*QB;
  const bf16*Qw=Q+(rowbase+q0+wid*QBLK)*DMQ+h*D;
  const bf16*Kh=K+rowbase*DMK+h*D,*Vh=V+rowbase*DMK+h*D;
  const unsigned lds0=(unsigned)(uintptr_t)shm;
  float*wsf=(float*)(shm+LDS_WS)+wid*64;
  const bf16*ksrc=Kh+(long)lane*DMK+wid*8;
  const bf16*vsrc=Vh+(long)(16*(wid&3)+(lane>>2))*DMK+(wid>>2)*32+(lane&3)*8;
  const unsigned kdst=lds0+LDS_K+wid*1024, vdst=lds0+LDS_V+wid*1024;
  #define DMA_K(t,slot) glds16(ksrc+(long)(t)*KVBLK*DMK,(unsigned)__builtin_amdgcn_readfirstlane(kdst+(slot)))
  #define DMA_V(t,slot) glds16(vsrc+(long)(t)*KVBLK*DMK,(unsigned)__builtin_amdgcn_readfirstlane(vdst+(slot)))
  const int vb0=(int)(lds0+LDS_V)+((lane>>4)&1)*32+(lane&3)*8+(4*hi+((lane&15)>>2))*64;
  const char*Kbase=shm+LDS_K; bf16x8 kf[8];
  const lds_cptr shm3=(lds_cptr)shm; const lds_cptr kp0=shm3+LDS_K+hi*1024+r32*16; const lds_cptr vp0=shm3+LDS_V+((lane>>4)&1)*32+(lane&3)*8+(4*hi+((lane&15)>>2))*64;
  const int j0=__builtin_amdgcn_readfirstlane(j0tab[(b*NHEAD+h)*NQB+qb]);
  { const float*Fh=Fp+(long)(b*NHEAD+h)*SEQ; const float fref=Fh[q0]; __attribute__((address_space(3))) float*fw=(__attribute__((address_space(3))) float*)((lds_cptr)shm+LDS_FSB);
    const float usub=FAST?qmaxv+(fref-Fh[q0+QB-1])*1.4426950408889634f:0.f;
    for(int s=j0*KVBLK+tid;s<q0+QB;s+=NW*64)fw[s]=(fref-Fh[s])*1.4426950408889634f-usub; }
  asm volatile("s_waitcnt vmcnt(0) lgkmcnt(0)":::"memory");
  const int NT=(q0+QB)/KVBLK-j0;
  ksrc+=(long)j0*KVBLK*DMK; vsrc+=(long)j0*KVBLK*DMK;
  const __attribute__((address_space(3))) float*fsb=(const __attribute__((address_space(3))) float*)((lds_cptr)shm+LDS_FSB)+4*hi+j0*KVBLK;
  DMA_K(0,0);DMA_V(0,0);DMA_K(1,SLOTB);
  bf16x8 qr[4];
  #pragma unroll
  for(int d0=0;d0<4;++d0)qr[d0]=*reinterpret_cast<const bf16x8*>(&Qw[(long)r32*DMQ+d0*16+hi*8]);
  float mhat=0.f,l_reg=0.f;f32x16 o[2];o[0]=f32x16{};o[1]=f32x16{};
  const int qrel=wid*QBLK+r32;
  #define CMASK(P0,P1,t) do{int jb_=(t)-(NT-4); if(jb_>=0)cmask(P0,P1,jb_,qrel,hi);}while(0)
  bool resc=false;
  typedef float f32x4b __attribute__((ext_vector_type(4)));
  #define BIASC(C0,C1,t) do{ const __attribute__((address_space(3))) float*fb_=fsb+(t)*KVBLK; \
    _Pragma("unroll") for(int g_=0;g_<4;++g_){ const f32x4b x_=*(const __attribute__((address_space(3))) f32x4b*)(fb_+8*g_); const f32x4b y_=*(const __attribute__((address_space(3))) f32x4b*)(fb_+32+8*g_); \
      _Pragma("unroll") for(int i_=0;i_<4;++i_){ C0[4*g_+i_]=FAST?x_[i_]:x_[i_]-mhat; C1[4*g_+i_]=FAST?y_[i_]:y_[i_]-mhat; } } }while(0)
  #define START(P0,P1) do{ const float rm=rowmax(P0,P1); resc=false; \
    { const float dl=rm; mhat=fadd_s(mhat,dl); \
      _Pragma("unroll") for(int r=0;r<16;++r){P0[r]=fsub_s(P0[r],dl);P1[r]=fsub_s(P1[r],dl);} } \
    _Pragma("unroll") for(int r=0;r<16;++r)P0[r]=__builtin_amdgcn_exp2f(P0[r]); }while(0)
  #define RESC() do{ if(resc){ asm volatile("s_waitcnt lgkmcnt(0)":::"memory"); \
      _Pragma("unroll") for(int d_=0;d_<2;++d_) _Pragma("unroll") for(int r=0;r<16;++r)o[d_][r]*=wsf[crow(r,hi)]; } }while(0)
  f32x16 pA0,pA1,pB0,pB1;
  int sl_prev=0,sl_cur=0,sl_next=SLOTB;
  #define ROT() do{sl_prev=sl_cur;sl_cur=sl_next;sl_next=(sl_next==(NSLOT-1)*SLOTB)?0:sl_next+SLOTB;}while(0)
  DMA_K(2,2*SLOTB);
  WAIT_BAR(3);
  if(!FAST)mhat=qmaxv+((const __attribute__((address_space(3))) float*)((lds_cptr)shm+LDS_FSB))[q0+qrel];
  BIASC(pA0,pA1,0); qkt(pA0,pA1,Kbase,qr,r32,hi);asm volatile("s_nop 15\n\ts_nop 7":"+v"(pA0),"+v"(pA1));
  CMASK(pA0,pA1,0); resc=false;
  _Pragma("unroll") for(int r=0;r<16;++r)pA0[r]=__builtin_amdgcn_exp2f(pA0[r]);
  _Pragma("unroll") for(int r=0;r<16;++r)pA1[r]=__builtin_amdgcn_exp2f(pA1[r]);
  WAIT_BAR(0);
  DMA_K(3,0);DMA_V(1,SLOTB);
  ROT();
  kload8(kf,kp0+sl_cur);
  WAIT_BAR(2);
  s16x4 vlo[8],vhi[8]; u32x4 pw0,pw1,pw2,pw3;
  #define PKW(P,B) cvtpk_s(P[B],P[B+1])
  #define PAF(k) __builtin_bit_cast(bf16x8,pw##k)
  #define VFR(i) (bf16x8){vlo[i][0],vlo[i][1],vlo[i][2],vlo[i][3],vhi[i][0],vhi[i][1],vhi[i][2],vhi[i][3]}
  #define PIN(x) asm volatile("":"+v"(x))
  #define MX3(a,b,c) __builtin_fmaxf(__builtin_fmaxf((a),(b)),(c))
  #define GAPA(MF,A0,A1,A2,A3,W0,W1,PW) do{ MF; sacc+=A0; sacc+=A1; sacc+=A2; sacc+=A3; PIN(sacc); W0; W1; PIN(PW); SBAR(); }while(0)
  #define EX(v) __builtin_amdgcn_exp2f(v)
  #define GAPB(MF,X,B) do{ MF; X[B]=EX(X[B]); X[B+1]=EX(X[B+1]); X[B+2]=EX(X[B+2]); X[B+3]=EX(X[B+3]); PIN(X); SBAR(); }while(0)
  #define VRD(i) do{ vlo[i]=vtr(vp_+(((i)>>2)*4096+((i)&3)*1024)); vhi[i]=vtr(vp_+(((i)>>2)*4096+((i)&3)*1024+512)); }while(0)
  #define KRD(G,j) do{ if(G){ kload2(kf,kp0+sl_next,j); SBAR(); } }while(0)
  #define STEP(C0,C1,P0,P1,t,GK,GV,GL) do{ SBAR(); \
    BIASC(C0,C1,t); SBAR(); \
    const lds_cptr vp_=vp0+sl_prev; \
    VRD(0); SBAR(); float sacc=(P0[0]+P0[1]); \
    GAPA(C0=__builtin_amdgcn_mfma_f32_32x32x16_bf16(kf[0],qr[0],C0,0,0,0), P0[2],P0[3],P0[4],P0[5],     pw0[0]=PKW(P0,0), pw0[1]=PKW(P0,2), pw0); \
    VRD(4); SBAR(); GAPA(C1=__builtin_amdgcn_mfma_f32_32x32x16_bf16(kf[1],qr[0],C1,0,0,0), P0[6],P0[7],P0[8],P0[9],     pw0[2]=PKW(P0,4), pw0[3]=PKW(P0,6), pw0); \
    VRD(1); SBAR(); GAPA(C0=__builtin_amdgcn_mfma_f32_32x32x16_bf16(kf[2],qr[1],C0,0,0,0),   P0[10],P0[11],P0[12],P0[13], pw1[0]=PKW(P0,8), pw1[1]=PKW(P0,10), pw1); \
    VRD(5); SBAR(); GAPA(C1=__builtin_amdgcn_mfma_f32_32x32x16_bf16(kf[3],qr[1],C1,0,0,0),   P0[14],P0[15],P1[0],P1[1],   pw1[2]=PKW(P0,12),pw1[3]=PKW(P0,14), pw1); \
    VRD(2); SBAR(); GAPA(C0=__builtin_amdgcn_mfma_f32_32x32x16_bf16(kf[4],qr[2],C0,0,0,0),   P1[2],P1[3],P1[4],P1[5],     pw2[0]=PKW(P1,0), pw2[1]=PKW(P1,2), pw2); \
    VRD(6); SBAR(); GAPA(C1=__builtin_amdgcn_mfma_f32_32x32x16_bf16(kf[5],qr[2],C1,0,0,0),   P1[6],P1[7],P1[8],P1[9],     pw2[2]=PKW(P1,4), pw2[3]=PKW(P1,6), pw2); \
    VRD(3); SBAR(); GAPA(C0=__builtin_amdgcn_mfma_f32_32x32x16_bf16(kf[6],qr[3],C0,0,0,0),   P1[10],P1[11],P1[12],P1[13], pw3[0]=PKW(P1,8), pw3[1]=PKW(P1,10), pw3); \
    VRD(7); SBAR(); GAPA(C1=__builtin_amdgcn_mfma_f32_32x32x16_bf16(kf[7],qr[3],C1,0,0,0),   P1[14],P1[15],0.f,0.f,       pw3[2]=PKW(P1,12),pw3[3]=PKW(P1,14), pw3); \
    l_reg+=sacc; \
    if(GK){DMA_K((t)+3,sl_cur);} if(GV){DMA_V((t)+1,sl_next);} \
    CMASK(C0,C1,t); \
    SBAR(); \
    GAPB(o[0]=__builtin_amdgcn_mfma_f32_32x32x16_bf16(PAF(0),VFR(0),o[0],0,0,0), C0,0); \
    GAPB(o[1]=__builtin_amdgcn_mfma_f32_32x32x16_bf16(PAF(0),VFR(4),o[1],0,0,0), C0,4); \
    KRD(GL,0); GAPB(o[0]=__builtin_amdgcn_mfma_f32_32x32x16_bf16(PAF(1),VFR(1),o[0],0,0,0), C0,8); \
    KRD(GL,1); GAPB(o[1]=__builtin_amdgcn_mfma_f32_32x32x16_bf16(PAF(1),VFR(5),o[1],0,0,0), C0,12); \
    KRD(GL,2); GAPB(o[0]=__builtin_amdgcn_mfma_f32_32x32x16_bf16(PAF(2),VFR(2),o[0],0,0,0), C1,0); \
    KRD(GL,3); GAPB(o[1]=__builtin_amdgcn_mfma_f32_32x32x16_bf16(PAF(2),VFR(6),o[1],0,0,0), C1,4); \
    GAPB(o[0]=__builtin_amdgcn_mfma_f32_32x32x16_bf16(PAF(3),VFR(3),o[0],0,0,0), C1,8); \
    GAPB(o[1]=__builtin_amdgcn_mfma_f32_32x32x16_bf16(PAF(3),VFR(7),o[1],0,0,0), C1,12); \
    }while(0)
  int t=1;
  #undef CMASK
  #define CMASK(P0,P1,t) do{}while(0)
  for(;t+5<NT;t+=2){
    STEP(pB0,pB1,pA0,pA1,t,true,true,true);     WAIT_BAR(2); RESC(); ROT();
    STEP(pA0,pA1,pB0,pB1,t+1,true,true,true);   WAIT_BAR(2); RESC(); ROT();
  }
  #undef CMASK
  #define CMASK(P0,P1,t) do{int jb_=(t)-(NT-4); if(jb_>=0)cmask(P0,P1,jb_,qrel,hi);}while(0)
  #define ENDW(tt) do{ if((tt)+3<NT){WAIT_BAR(2);} else if((tt)+2<NT){WAIT_BAR(1);} else {WAIT_BAR(0);} }while(0)
  for(;t+1<NT;t+=2){
    STEP(pB0,pB1,pA0,pA1,t,(t+3<NT),(t+1<NT),(t+1<NT));       ENDW(t);   RESC(); ROT();
    STEP(pA0,pA1,pB0,pB1,t+1,(t+4<NT),(t+2<NT),(t+2<NT));     ENDW(t+1); RESC(); ROT();
  }
  STEP(pB0,pB1,pA0,pA1,NT-1,false,false,false); RESC();
  { float sacc=pB0[0]+pB0[1]; _Pragma("unroll") for(int r=2;r<16;++r)sacc+=pB0[r]; _Pragma("unroll") for(int r=0;r<16;++r)sacc+=pB1[r]; l_reg+=sacc;
    pw0=(u32x4){PKW(pB0,0),PKW(pB0,2),PKW(pB0,4),PKW(pB0,6)};pw1=(u32x4){PKW(pB0,8),PKW(pB0,10),PKW(pB0,12),PKW(pB0,14)};pw2=(u32x4){PKW(pB1,0),PKW(pB1,2),PKW(pB1,4),PKW(pB1,6)};pw3=(u32x4){PKW(pB1,8),PKW(pB1,10),PKW(pB1,12),PKW(pB1,14)};
    SBAR(); pv(o,vb0+sl_cur,PAF(0),PAF(1),PAF(2),PAF(3)); }
  #undef PKW
  #undef PAF
  #undef VFR
  #undef PIN
  #undef MX3
  #undef GAPA
  #undef GAPB
  #undef EX
  #undef VRD
  #undef KRD
  #undef STEP
  #undef ENDW
  {auto rr=__builtin_amdgcn_permlane32_swap(__float_as_uint(l_reg),__float_as_uint(l_reg),false,false);l_reg=__uint_as_float(rr[0])+__uint_as_float(rr[1]);}
  if(hi==0)wsf[32+r32]=l_reg;asm volatile("s_waitcnt lgkmcnt(0)":::"memory");
  float rli[16];
  #pragma unroll
  for(int r=0;r<16;++r)rli[r]=__builtin_amdgcn_rcpf(wsf[32+crow(r,hi)]);
  bf16*Ow=O+(rowbase+q0+wid*QBLK)*DMQ+h*D;
  { bf16*stg=(bf16*)(shm+LDS_OST)+wid*2048;
    #pragma unroll
    for(int r=0;r<16;++r){const int orow=crow(r,hi);
      #pragma unroll
      for(int d0=0;d0<2;++d0)stg[orow*64+d0*32+r32]=__float2bfloat16(o[d0][r]*rli[r]);}
    asm volatile("s_waitcnt lgkmcnt(0)":::"memory");
    #pragma unroll
    for(int i=0;i<4;++i){const int row=i*8+(lane>>3),ch=lane&7; const u32x4 v=*(const u32x4*)(stg+row*64+ch*8); ATTN_STORE16(Ow+(long)row*DMQ+ch*8,v);} }
  asm volatile("s_waitcnt lgkmcnt(0)\n\ts_barrier":::"memory");
  #undef DMA_K
  #undef DMA_V
  #undef CMASK
  #undef START
  #undef BIASC
  #undef RESC
  #undef ROT
}
constexpr int ATTN_LDS_BYTES=LDS_TOTAL;
struct AttnTensors { const bf16* Q; const bf16* K; const bf16* V; bf16* O; const float* Fp; const int* j0tab; float qmax; };
struct AttnUnit { int bh; int qb; };
struct StaticOrder {
  int vcu;
  __device__ __forceinline__ explicit StaticOrder(int grid,int block):vcu((block%8)*(grid/8)+block/8){}
  __device__ __forceinline__ bool next(int i,AttnUnit&u)const{ if(i>=4)return false; const int s=vcu&7; u.bh=vcu>>3; u.qb=(i==0)?s:(i==1)?15-s:(i==2)?16+s:31-s; return true; }
  __device__ __forceinline__ void a_ready(const AttnUnit&)const{}
  __device__ __forceinline__ void done(const AttnUnit&)const{}
};
template<class Sched,int THRL=8> __device__ __forceinline__ void attn_phase(char*lds,const AttnTensors&T,const Sched&S){
  AttnUnit u;
  for(int i=0;S.next(i,u);++i){ S.a_ready(u);
    const float*Fh=T.Fp+(long)u.bh*SEQ; const float dspan=(Fh[u.qb*QB]-Fh[u.qb*QB+QB-1])*1.4426950408889634f;
    if(__builtin_amdgcn_readfirstlane((int)(2.0f*T.qmax+dspan<110.0f))) attn_unit<THRL,true>(u.bh/NHEAD,u.bh%NHEAD,u.qb,T.Q,T.K,T.V,T.O,T.Fp,T.j0tab,T.qmax,lds);
    else attn_unit<THRL,false>(u.bh/NHEAD,u.bh%NHEAD,u.qb,T.Q,T.K,T.V,T.O,T.Fp,T.j0tab,T.qmax,lds);
    S.done(u); }
}
#undef SBAR
#undef WAIT_BAR
}
#define GAS __attribute__((address_space(1)))
#define LAS __attribute__((address_space(3)))
typedef unsigned short bf16;
typedef unsigned v4u __attribute__((ext_vector_type(4)));
typedef float f32x4 __attribute__((ext_vector_type(4)));
typedef short bf16x8 __attribute__((ext_vector_type(8)));
typedef GAS unsigned gu32;
typedef GAS unsigned long long gu64;
#define RLX_AGENT __ATOMIC_RELAXED, __HIP_MEMORY_SCOPE_AGENT
#define LDS_WAIT() asm volatile("s_waitcnt lgkmcnt(0)" ::: "memory")
#define VM_WAIT() asm volatile("s_waitcnt vmcnt(0)" ::: "memory")
__device__ __forceinline__ unsigned long long rt() { return __builtin_amdgcn_s_memrealtime(); }
__device__ __forceinline__ unsigned f2bf(float f) { unsigned u = __builtin_bit_cast(unsigned, f); return (u + 0x7fffu + ((u >> 16) & 1u)) >> 16; }
__device__ __forceinline__ unsigned pk2(float lo, float hi) { return f2bf(lo) | (f2bf(hi) << 16); }

#define XB_TMO      128
#define XB_XCNT(j)  (256  + 64 * (j))
#define XB_XSUB(j)  (1280 + 64 * (j))
#define XB_XGEN(j)  (2304 + 64 * (j))
#define XB_TOP      3328
#define XB_TOPGEN   3392
#define XB_FLAG(j)  (3456 + 64 * (j))
#define XCD_BAR_WORDS 4480
#define XB_SPIN_CAP (1u << 18)

__device__ __forceinline__ unsigned xb_ld(unsigned* p)              { return __hip_atomic_load(p, __ATOMIC_RELAXED, __HIP_MEMORY_SCOPE_AGENT); }
__device__ __forceinline__ unsigned xb_add(unsigned* p, unsigned v) { return __hip_atomic_fetch_add(p, v, __ATOMIC_RELAXED, __HIP_MEMORY_SCOPE_AGENT); }
__device__ __forceinline__ unsigned xb_xcc_id() { return (unsigned)__builtin_amdgcn_s_getreg((3 << 11) | 20) & 0xFu; }
#define XB_SPIN(cond, bar) do { unsigned _sp = 0; while (cond) { __builtin_amdgcn_s_sleep(1); \
    if ((++_sp & 255u) == 0u) { if (xb_ld(&(bar)[XB_TMO])) break; if (_sp > XB_SPIN_CAP) { atomicAdd(&(bar)[XB_TMO], 1u); break; } } } } while (0)

struct XcdBarrier {
    unsigned* bar; unsigned x;
    volatile LAS unsigned* st;
};

__device__ __forceinline__ XcdBarrier xcd_barrier_post(unsigned* bar, volatile LAS unsigned* st) {
    XcdBarrier b; b.bar = bar; b.x = xb_xcc_id(); b.st = st;
    if (threadIdx.x == 0) (void)xb_add(&bar[XB_XCNT(b.x)], 1u);
    return b;
}
__device__ __forceinline__ void xcd_barrier_complete(unsigned* bar, unsigned x, unsigned& nloc, unsigned& nx) {
    const unsigned G = gridDim.x * gridDim.y * gridDim.z;
    unsigned sum, cnt, mine, msk, sp = 0u;
    for (;;) {
        sum = 0u; cnt = 0u; mine = 0u; msk = 0u;
#pragma unroll
        for (unsigned j = 0; j < 16; ++j) { const unsigned c = xb_ld(&bar[XB_XCNT(j)]); sum += c; cnt += (c > 0u) ? 1u : 0u; msk |= (c > 0u) ? (1u << j) : 0u; mine = (j == x) ? c : mine; }
        if (sum == G) break;
        __builtin_amdgcn_s_sleep(1);
        if ((++sp & 255u) == 0u) { if (xb_ld(&bar[XB_TMO])) break; if (sp > XB_SPIN_CAP) { atomicAdd(&bar[XB_TMO], 1u); break; } }
    }
    nloc = mine > 0u ? mine : 1u; nx = msk;
}

__device__ __forceinline__ void xcd_barrier(const XcdBarrier& b) {
    asm volatile("s_waitcnt vmcnt(0)" ::: "memory");
    __syncthreads();
    if (threadIdx.x == 0) {
        unsigned* bar = b.bar;
        __builtin_amdgcn_s_waitcnt(0);
        unsigned nloc = b.st[0], nx = b.st[1];
        if (nloc == 0u) { xcd_barrier_complete(bar, b.x, nloc, nx); b.st[0] = nloc; b.st[1] = nx; }
        const unsigned old = xb_add(&bar[XB_XSUB(b.x)], 1u);
        const unsigned gen = old / nloc;
        if (old + 1u == (gen + 1u) * nloc) {
            __builtin_amdgcn_fence(__ATOMIC_RELEASE, "agent");
            asm volatile("s_waitcnt vmcnt(0)" ::: "memory");
            __hip_atomic_store(&bar[XB_FLAG(b.x)], gen + 1u, __ATOMIC_RELAXED, __HIP_MEMORY_SCOPE_AGENT);
            { unsigned _sp = 0;
              for (;;) { unsigned ok = 1u;
#pragma unroll
                  for (unsigned j = 0; j < 16; ++j) { const unsigned f = xb_ld(&bar[XB_FLAG(j)]); ok &= (((nx >> j) & 1u) == 0u || f > gen) ? 1u : 0u; }
                  if (ok) break;
                  __builtin_amdgcn_s_sleep(1);
                  if ((++_sp & 255u) == 0u) { if (xb_ld(&bar[XB_TMO])) break; if (_sp > XB_SPIN_CAP) { atomicAdd(&bar[XB_TMO], 1u); break; } } } }
            __builtin_amdgcn_fence(__ATOMIC_ACQUIRE, "agent");
            xb_add(&bar[XB_XGEN(b.x)], 1u);
            asm volatile("s_waitcnt vmcnt(0)" ::: "memory");
        } else {
            XB_SPIN(xb_ld(&bar[XB_XGEN(b.x)]) == gen, bar);
            __builtin_amdgcn_fence(__ATOMIC_ACQUIRE, "agent");
            asm volatile("s_waitcnt vmcnt(0)" ::: "memory");
        }
    }
    __syncthreads();
}
constexpr int NWAVES = 8;
#ifndef MK_N_LAUNCHES
#define MK_N_LAUNCHES 1
#endif
constexpr int N_PHASES = 12;
constexpr int N_LAUNCHES = MK_N_LAUNCHES;
static_assert(N_LAUNCHES == 1 || N_LAUNCHES == N_PHASES, "MK_N_LAUNCHES is 1 or 12");

constexpr int D = 1024, FF = 2816, NUP = 2 * FF, DATT = 512, NH = 8, HD = 64, DCONV = 512, CW = 31, CS = 30;
constexpr int TP = 8192, NBP = 4, MP = NBP * TP, NBS = 16, TS = 16, MS = NBS * TS, M = MP + MS, PAST = 2048;
constexpr int NIN = 2560, DIN = 2568, NMOD = 9, MODW = NMOD * D, NB = NBP + NBS;
constexpr float EPS = 1e-6f, LOG2E = 1.4426950408889634f;
static_assert(MODW == pg8::EP_MODW && M % 256 == 0, "shapes");
constexpr size_t O_YP = 0, O_YS = O_YP + (size_t)MP * D, O_KP = O_YS + (size_t)MS * D, O_VP = O_KP + (size_t)MP * DATT, O_LP = O_VP + (size_t)MP * DATT,
    O_CP = O_LP + (size_t)MP * NH, O_KS = O_CP + (size_t)NBP * CS * DCONV, O_VS = O_KS + (size_t)MS * DATT, O_LS = O_VS + (size_t)MS * DATT, O_CS = O_LS + (size_t)MS * NH,
    O_END = O_CS + (size_t)NBS * CS * DCONV;
static_assert(O_END == 68204544, "output size");
enum { I_XP = 0, I_XS, I_CP, I_CSM, I_CK, I_CV, I_CLF, I_SCONV, I_WADA, I_BADA, I_GFFN1, I_WUP1, I_WDN1, I_GMIX, I_WIN, I_BF, I_GQ, I_GK, I_CONVW, I_CONVB, I_LNG, I_LNB, I_WOUT, I_GFFN2, I_WUP2, I_WDN2, I_GFIN, N_IN };
static_assert(N_IN == 27, "inputs");

constexpr size_t MiB = 1u << 20;
constexpr size_t WS_CTL = 0, CTL_ZERO_BYTES = 64 * 1024;
constexpr size_t WS_MODP = 1 * MiB;
constexpr size_t WS_MOD = 4 * MiB;
constexpr size_t WS_J0 = 7 * MiB;
constexpr size_t WS_FP = 5 * MiB;
constexpr size_t WS_WUP1 = 8 * MiB, WS_WDN1 = 19 * MiB, WS_WIN = 25 * MiB, WS_WOUT = 30 * MiB, WS_WUP2 = 32 * MiB, WS_WDN2 = 43 * MiB;
constexpr size_t WS_HN = 50 * MiB;
constexpr size_t WS_X = 116 * MiB;
constexpr size_t WS_HID = 246 * MiB;
constexpr size_t WS_A2 = 246 * MiB, WS_KB = 311 * MiB, WS_VB = 344 * MiB, WS_UB = 377 * MiB;
constexpr size_t WS_PART = 424 * MiB;
constexpr size_t WS_SPRIV = 436 * MiB;
constexpr size_t WS_XSB = 442 * MiB;
constexpr size_t WS_XSA = 443 * MiB;
constexpr size_t WS_END = 444 * MiB;
static_assert(WS_MODP + 4ull * NB * MODW * 4 <= WS_MOD && WS_MOD + (size_t)NB * MODW * 4 <= WS_FP && WS_FP + (size_t)NBP * NH * TP * 4 <= WS_WUP1, "ws map 1");
static_assert(WS_WUP1 + (size_t)NUP * D * 2 <= WS_WDN1 && WS_WDN1 + (size_t)D * FF * 2 <= WS_WIN && WS_WIN + (size_t)NIN * D * 2 <= WS_WOUT && WS_WOUT + (size_t)D * D * 2 <= WS_WUP2 && WS_WUP2 + (size_t)NUP * D * 2 <= WS_WDN2 && WS_WDN2 + (size_t)D * FF * 2 <= WS_HN, "ws map 2");
static_assert(WS_HN + (size_t)M * D * 2 <= WS_X && WS_X + (size_t)M * D * 4 <= WS_HID && WS_HID + (size_t)M * FF * 2 <= WS_PART && WS_PART + 11ull * 256 * 1024 * 4 <= WS_SPRIV && WS_SPRIV + 22ull * 256 * 1024 <= WS_XSB && WS_SPRIV + 10ull * 256 * 1024 * 2 <= WS_XSB && WS_XSB + 256ull * 1024 * 4 <= WS_XSA && WS_XSA + 256ull * 1024 * 4 <= WS_END, "ws map 3");
static_assert(WS_A2 + (size_t)M * D * 2 <= WS_KB && WS_KB + (size_t)M * DATT * 2 <= WS_VB && WS_VB + (size_t)M * DATT * 2 <= WS_UB && WS_UB + (size_t)M * DCONV * 2 <= WS_PART, "ws map 4");
constexpr int CW_BAR = 4096, CW_AQ = 1024, CW_SUB = 2048;

constexpr int RING_OFF = 0, RING_BYTES = 131072;
constexpr int LDSCTL_OFF = RING_BYTES, MISC_OFF = LDSCTL_OFF + 320;
constexpr int LDS_BYTES = 147456;
static_assert(MISC_OFF + 128 <= LDS_BYTES && attn_body::ATTN_LDS_BYTES <= RING_BYTES, "LDS map");

struct Frame {
    LAS unsigned char* lds;
    volatile LAS unsigned* MISC;
    int wave;
    int vcu, G;
};
__device__ __forceinline__ const float* inp_ptr(int i) { asm volatile("" : "+s"(i)); return ((const float* const __attribute__((address_space(4)))*)__builtin_amdgcn_kernarg_segment_ptr())[i]; }
#define INP(i) inp_ptr(i)
#define OUTP() ((float*)inp_ptr(N_IN))
#define WSP() ((unsigned char*)inp_ptr(N_IN + 1))
__device__ __forceinline__ float wave_sum(float v) { return xsum32(xsum16(row_sum16(v))); }
__device__ __forceinline__ float wave_max(float v) { return xmax32(xmax16(row_max16(v))); }
__device__ __forceinline__ float bf2f(bf16 b) { return __builtin_bit_cast(float, (unsigned)b << 16); }

__device__ __forceinline__ void p0_mod_task(Frame& F, int task) {
    unsigned char* const ws_ = WSP();
    const int cu = task >> 2, kq = task & 3;
    LAS float* sc = (LAS float*)(F.lds);
    LAS float* red = (LAS float*)(F.lds + 20480);
    const float* cpp = INP(I_CP); const float* csp = INP(I_CSM);
    for (int e = ((int)threadIdx.x); e < NB * 256; e += NWAVES * 64) { const int r = e >> 8, j = e & 255; const float c = r < NBP ? cpp[r * D + 256 * kq + j] : csp[(r - NBP) * D + 256 * kq + j]; sc[e] = c / (1.0f + __expf(-c)); }
    __syncthreads();
    f32x4 acc[NB];
#pragma unroll
    for (int r = 0; r < NB; ++r) acc[r] = (f32x4){0.f, 0.f, 0.f, 0.f};
    const float* Wp = INP(I_WADA) + (size_t)(256 * kq + 32 * F.wave) * MODW + 256 * cu + 4 * ((int)(threadIdx.x & 63));
#pragma unroll 1
    for (int i = 0; i < 32; i += 4) {
        f32x4 w[4];
#pragma unroll
        for (int ii = 0; ii < 4; ++ii) w[ii] = __builtin_nontemporal_load((const f32x4*)(Wp + (size_t)(i + ii) * MODW));
#pragma unroll
        for (int r = 0; r < NB; ++r) { const f32x4 s = *(const LAS f32x4*)(sc + r * 256 + 32 * F.wave + i); acc[r] += s[0] * w[0] + s[1] * w[1] + s[2] * w[2] + s[3] * w[3]; }
    }
#pragma unroll
    for (int half = 0; half < 2; ++half) {
#pragma unroll
        for (int r = 0; r < 10; ++r) *(LAS f32x4*)(red + (F.wave * 10 + r) * 256 + 4 * ((int)(threadIdx.x & 63))) = acc[half * 10 + r];
        __syncthreads();
        for (int e = ((int)threadIdx.x); e < 2560; e += NWAVES * 64) { const int r = e >> 8, c = e & 255; float s = 0.f;
#pragma unroll
            for (int w = 0; w < NWAVES; ++w) s += red[(w * 10 + r) * 256 + c];
            ((float*)(ws_ + WS_MODP))[((size_t)kq * NB + half * 10 + r) * MODW + 256 * cu + c] = s; }
        __syncthreads();
    }
}
__device__ __forceinline__ void p0_transpose_item(const float* W, int K, int Nsrc, bf16* WT, int n0, int c0, LAS float* scr, int kb, int lane) {
    const int k0 = 64 * kb;
#pragma unroll 8
    for (int i = 0; i < 32; ++i) { const int kk = 2 * i + (lane >> 5); scr[kk * 33 + (lane & 31)] = W[(size_t)(k0 + kk) * Nsrc + c0 + (lane & 31)]; }
    LDS_WAIT(); asm volatile("" ::: "memory");
    const int c = lane & 7;
#pragma unroll
    for (int j = 0; j < 4; ++j) { const int n = (lane >> 3) + 8 * j; const LAS float* s = scr + (8 * c) * 33 + n;
        v4u o; o.x = pk2(s[0 * 33], s[1 * 33]); o.y = pk2(s[2 * 33], s[3 * 33]); o.z = pk2(s[4 * 33], s[5 * 33]); o.w = pk2(s[6 * 33], s[7 * 33]);
        *(GAS v4u*)(WT + (size_t)(n0 + n) * K + k0 + 8 * c) = o; }
    LDS_WAIT(); asm volatile("" ::: "memory");
}
__device__ __forceinline__ void p0_transpose_item_fp8(const float* W, int K, int Nsrc, unsigned char* WT8, int n0, int c0, LAS float* scr, int kb, int lane) {
    const int k0 = 64 * kb;
#pragma unroll 8
    for (int i = 0; i < 32; ++i) { const int kk = 2 * i + (lane >> 5); scr[kk * 33 + (lane & 31)] = W[(size_t)(k0 + kk) * Nsrc + c0 + (lane & 31)]; }
    LDS_WAIT(); asm volatile("" ::: "memory");
    const int n = lane >> 1, kh = lane & 1; const LAS float* s = scr + (32 * kh) * 33 + n;
    v4u o[2];
#pragma unroll
    for (int q = 0; q < 8; ++q) { int w = 0; w = __builtin_amdgcn_cvt_pk_fp8_f32(64.0f * s[(4 * q) * 33], 64.0f * s[(4 * q + 1) * 33], w, false); w = __builtin_amdgcn_cvt_pk_fp8_f32(64.0f * s[(4 * q + 2) * 33], 64.0f * s[(4 * q + 3) * 33], w, true); o[q >> 2][q & 3] = (unsigned)w; }
    GAS v4u* d = (GAS v4u*)(WT8 + (size_t)(n0 + n) * K + k0 + 32 * kh); d[0] = o[0]; d[1] = o[1];
    LDS_WAIT(); asm volatile("" ::: "memory");
}
__device__ __forceinline__ int up_src_col(int n0) { const int pn = n0 >> 8, loc = n0 & 255; return loc < 128 ? 128 * pn + loc : FF + 128 * pn + (loc - 128); }
__device__ __forceinline__ int in_src_col(int n0) { const int pn = n0 >> 8, loc = n0 & 255;
    if (pn < 6) { const int sec = pn >> 1, bj = loc >> 7, wc = (loc & 127) >> 5, head = 4 * (pn & 1) + wc; return sec * DATT + head * HD + 32 * bj; }
    return loc < 128 ? (3 * DATT + NH) + 128 * (pn - 6) + loc : (3 * DATT + NH + DCONV) + 128 * (pn - 6) + (loc - 128); }
__device__ __forceinline__ void p0_prologue(Frame& F) {
    unsigned char* const ws_ = WSP(); float* const out_ = OUTP();
    if ((int)blockIdx.x < 144) { for (int task = blockIdx.x; task < 144; task += F.G) p0_mod_task(F, task); }
    __syncthreads();
    LAS float* scr = (LAS float*)(F.lds + RING_OFF + F.wave * 16384);
    const int gw = F.vcu * NWAVES + F.wave, NGW = F.G * NWAVES;
    constexpr int I_UP = (D / 64) * (NUP / 32), I_DN = (FF / 64) * (D / 32), I_IN = (D / 64) * (NIN / 32), I_OUT = (D / 64) * (D / 32);
    constexpr int NITEMS = 2 * I_UP + 2 * I_DN + I_IN + I_OUT;
    for (int it = gw; it < NITEMS; it += NGW) {
        int r = it;
        if (r < I_UP) { const int nb = r % (NUP / 32), kb = r / (NUP / 32); p0_transpose_item_fp8(INP(I_WUP1), D, NUP, ws_ + WS_WUP1, 32 * nb, up_src_col(32 * nb), scr, kb, ((int)(threadIdx.x & 63))); continue; } r -= I_UP;
        if (r < I_UP) { const int nb = r % (NUP / 32), kb = r / (NUP / 32); p0_transpose_item_fp8(INP(I_WUP2), D, NUP, ws_ + WS_WUP2, 32 * nb, up_src_col(32 * nb), scr, kb, ((int)(threadIdx.x & 63))); continue; } r -= I_UP;
        if (r < I_DN) { const int nb = r % (D / 32), kb = r / (D / 32); p0_transpose_item_fp8(INP(I_WDN1), FF, D, ws_ + WS_WDN1, 32 * nb, 32 * nb, scr, kb, ((int)(threadIdx.x & 63))); continue; } r -= I_DN;
        if (r < I_DN) { const int nb = r % (D / 32), kb = r / (D / 32); p0_transpose_item_fp8(INP(I_WDN2), FF, D, ws_ + WS_WDN2, 32 * nb, 32 * nb, scr, kb, ((int)(threadIdx.x & 63))); continue; } r -= I_DN;
        if (r < I_IN) { const int nb = r % (NIN / 32), kb = r / (NIN / 32); p0_transpose_item(INP(I_WIN), D, DIN, (bf16*)(ws_ + WS_WIN), 32 * nb, in_src_col(32 * nb), scr, kb, ((int)(threadIdx.x & 63))); continue; } r -= I_IN;
        { const int nb = r % (D / 32), kb = r / (D / 32); p0_transpose_item(INP(I_WOUT), D, D, (bf16*)(ws_ + WS_WOUT), 32 * nb, 32 * nb, scr, kb, ((int)(threadIdx.x & 63))); }
    }
    const float* scp = INP(I_SCONV);
    for (int e = (int)blockIdx.x * NWAVES * 64 + ((int)threadIdx.x); e < NBS * 14 * DCONV; e += F.G * NWAVES * 64) { const int b = e / (14 * DCONV), rem = e % (14 * DCONV);
        out_[O_CS + (size_t)b * CS * DCONV + rem] = scp[(size_t)b * CS * DCONV + 16 * DCONV + rem]; }
}

__device__ __forceinline__ f32x4 nr_bf4(const unsigned* p) { const unsigned a = p[0], b = p[1]; f32x4 r; r[0] = __builtin_bit_cast(float, a << 16); r[1] = __builtin_bit_cast(float, a & 0xffff0000u); r[2] = __builtin_bit_cast(float, b << 16); r[3] = __builtin_bit_cast(float, b & 0xffff0000u); return r; }
template <int KIND, bool SRCBF = false> __device__ __forceinline__ void norm_rows(Frame& F, const float* src, bf16* dst, float* dstf, float* dlogf, int nr, int bi, const float* part = nullptr, int npart = 0, float* xw = nullptr) {
    unsigned char* const ws_ = WSP();
    const int lane = ((int)(threadIdx.x & 63));
    f32x4 wv[4], shv[4];
    const float* g = INP(KIND == 1 ? I_GFFN1 : KIND == 2 ? I_GMIX : KIND == 3 ? I_GFFN2 : I_GFIN); const float* bada = INP(I_BADA);
#pragma unroll
    for (int j = 0; j < 4; ++j) { const int k = 4 * lane + 256 * j; const f32x4 gv = *(const f32x4*)(g + k);
        if (KIND == 4) { wv[j] = gv; shv[j] = (f32x4){0.f, 0.f, 0.f, 0.f}; }
        else if (KIND == 1) { const float* mp = (const float*)(ws_ + WS_MODP) + (size_t)bi * MODW + k; f32x4 sh = *(const f32x4*)(bada + k), sc = *(const f32x4*)(bada + D + k);
#pragma unroll
            for (int q = 0; q < 4; ++q) { sh += *(const f32x4*)(mp + (size_t)q * NB * MODW); sc += *(const f32x4*)(mp + (size_t)q * NB * MODW + D); }
            wv[j] = gv * (sc + 1.0f); shv[j] = sh; }
        else { const float* mp = (const float*)(ws_ + WS_MOD) + (size_t)bi * MODW + (KIND == 2 ? 3 : 6) * D + k; const f32x4 sh = *(const f32x4*)mp, sc = *(const f32x4*)(mp + D); wv[j] = gv * (sc + 1.0f); shv[j] = sh; } }
    f32x4 wf[KIND == 2 ? 32 : 1];
    float bfv = 0.f;
    if (KIND == 2) { const float* winp = INP(I_WIN);
#pragma unroll
        for (int j = 0; j < 4; ++j)
#pragma unroll
            for (int i = 0; i < 4; ++i) { const float* wp = winp + (size_t)(4 * lane + 256 * j + i) * DIN + 3 * DATT; wf[2 * (4 * j + i)] = *(const f32x4*)wp; wf[2 * (4 * j + i) + 1] = *(const f32x4*)(wp + 4); }
        bfv = INP(I_BF)[lane & 7];
    }
    constexpr int RPI = KIND == 2 ? 1 : 2;
#define NR_LD(rr, j) (SRCBF ? nr_bf4((const unsigned*)((const bf16*)(const void*)src + (size_t)(rr) * D + 4 * lane + 256 * (j))) : *(const f32x4*)(src + (size_t)(rr) * D + 4 * lane + 256 * (j)))
    f32x4 vn[RPI][4];
#pragma unroll
    for (int q = 0; q < RPI; ++q) {
#pragma unroll
        for (int j = 0; j < 4; ++j) vn[q][j] = NR_LD(q, j); }
#pragma unroll 1
    for (int r = 0; r < nr; r += RPI) {
        f32x4 v[RPI][4];
#pragma unroll
        for (int q = 0; q < RPI; ++q)
#pragma unroll
            for (int j = 0; j < 4; ++j) v[q][j] = vn[q][j];
        if (r + RPI < nr) {
#pragma unroll
            for (int q = 0; q < RPI; ++q) {
#pragma unroll
                for (int j = 0; j < 4; ++j) vn[q][j] = NR_LD(r + RPI + q, j); } }
        if (npart) {
            for (int p = 0; p < npart; ++p) {
#pragma unroll
                for (int q = 0; q < RPI; ++q) { const float* pp = part + (size_t)p * 256 * D + (size_t)(r + q) * D + 4 * lane;
#pragma unroll
                    for (int j = 0; j < 4; ++j) v[q][j] += *(const f32x4*)(pp + 256 * j); } }
            if (xw) {
#pragma unroll
                for (int q = 0; q < RPI; ++q)
#pragma unroll
                    for (int j = 0; j < 4; ++j) *(f32x4*)(xw + (size_t)(r + q) * D + 4 * lane + 256 * j) = v[q][j]; }
        }
        float ss[RPI];
#pragma unroll
        for (int q = 0; q < RPI; ++q) { ss[q] = 0.f;
#pragma unroll
            for (int j = 0; j < 4; ++j) ss[q] += (v[q][j][0] * v[q][j][0] + v[q][j][1] * v[q][j][1]) + (v[q][j][2] * v[q][j][2] + v[q][j][3] * v[q][j][3]); }
#pragma unroll
        for (int q = 0; q < RPI; ++q) ss[q] = wave_sum(ss[q]);
#pragma unroll
        for (int q = 0; q < RPI; ++q) { const float rstd = 1.0f / sqrtf(ss[q] * (1.0f / D) + EPS);
#pragma unroll
            for (int j = 0; j < 4; ++j) v[q][j] = v[q][j] * rstd * wv[j] + shv[j]; }
#pragma unroll
        for (int q = 0; q < RPI; ++q) {
            if (KIND == 4) {
#pragma unroll
                for (int j = 0; j < 4; ++j) __builtin_nontemporal_store(v[q][j], (f32x4*)(dstf + (size_t)(r + q) * D + 4 * lane + 256 * j));
            } else if (KIND == 1 || KIND == 3) {
                GAS unsigned* o4 = (GAS unsigned*)((unsigned char*)dst + (size_t)(r + q) * D) + lane;
#pragma unroll
                for (int j = 0; j < 4; ++j) { int w = 0; w = __builtin_amdgcn_cvt_pk_fp8_f32(v[q][j][0], v[q][j][1], w, false); w = __builtin_amdgcn_cvt_pk_fp8_f32(v[q][j][2], v[q][j][3], w, true); o4[64 * j] = (unsigned)w; }
            } else {
                GAS unsigned long long* o8 = (GAS unsigned long long*)(dst + (size_t)(r + q) * D) + lane;
#pragma unroll
                for (int j = 0; j < 4; ++j) o8[64 * j] = (unsigned long long)pk2(v[q][j][0], v[q][j][1]) | ((unsigned long long)pk2(v[q][j][2], v[q][j][3]) << 32);
            } }
        if (KIND == 2) {
#pragma unroll
            for (int q = 0; q < RPI; ++q) {
                f32x4 f0 = (f32x4){0.f, 0.f, 0.f, 0.f}, f1 = f0;
#pragma unroll
                for (int j = 0; j < 4; ++j)
#pragma unroll
                    for (int i = 0; i < 4; ++i) { f0 += v[q][j][i] * wf[2 * (4 * j + i)]; f1 += v[q][j][i] * wf[2 * (4 * j + i) + 1]; }
                float fl[8] = {f0[0], f0[1], f0[2], f0[3], f1[0], f1[1], f1[2], f1[3]};
#pragma unroll
                for (int h = 0; h < 4; ++h) { const float a = fl[h], b = fl[h + 4]; const bool up = (lane & 4) != 0; const float send = up ? a : b, keep = up ? b : a; fl[h] = keep + __shfl_xor(send, 4); }
#pragma unroll
                for (int h = 0; h < 2; ++h) { const float a = fl[h], b = fl[h + 2]; const bool up = (lane & 2) != 0; const float send = up ? a : b, keep = up ? b : a; fl[h] = keep + wr_dpp<0x4e>(send); }
                { const float a = fl[0], b = fl[1]; const bool up = (lane & 1) != 0; const float send = up ? a : b, keep = up ? b : a; fl[0] = keep + wr_dpp<0xb1>(send); }
                float mine = fl[0];
                mine += wr_dpp<0x128>(mine); mine = xsum32(xsum16(mine));
                const float z = mine + bfv;
                const float lf = fminf(z, 0.f) - log1pf(__expf(-fabsf(z)));
                if (lane < 8) dlogf[(size_t)(r + q) * NH + lane] = lf;
            }
        }
    }
}
#undef NR_LD
template <int KIND> __device__ __forceinline__ void norm_phase(Frame& F, int nskip) {
    unsigned char* const ws_ = WSP(); float* const out_ = OUTP();
    bf16* HN = (bf16*)(ws_ + WS_HN);
    if (KIND == 1) {
        const float* mp = (const float*)(ws_ + WS_MODP); float* mo = (float*)(ws_ + WS_MOD); const float* bada = INP(I_BADA);
        for (int e = (int)blockIdx.x * NWAVES * 64 + ((int)threadIdx.x); e < NB * MODW; e += F.G * NWAVES * 64)
            mo[e] = ((mp[e] + mp[e + (size_t)NB * MODW]) + (mp[e + 2 * (size_t)NB * MODW] + mp[e + 3 * (size_t)NB * MODW])) + bada[e % MODW];
    }
    const float* xpp = KIND == 1 ? INP(I_XP) : (const float*)(ws_ + WS_X);     const float* xsp = (const float*)(ws_ + WS_XSB);
    const float* part = (const float*)(ws_ + WS_PART); const int npart = 5;
    if ((int)blockIdx.x >= nskip) {
        const int nwv = (F.G - nskip) * NWAVES, gwp = ((int)blockIdx.x - nskip) * NWAVES + F.wave, R = ((MP + nwv - 1) / nwv + 1) & ~1;
        int a = gwp * R; const int bnd = a + R < MP ? a + R : MP;
        while (a < bnd) { const int bi = a / TP, e = (bi + 1) * TP < bnd ? (bi + 1) * TP : bnd;
            norm_rows<KIND, KIND != 1>(F, KIND == 1 ? xpp + (size_t)a * D : (const float*)((const bf16*)(const void*)xpp + (size_t)a * D), (KIND == 1 || KIND == 3) ? (bf16*)((unsigned char*)HN + (size_t)a * D) : HN + (size_t)a * D, out_ + O_YP + (size_t)a * D, out_ + O_LP + (size_t)a * NH, e - a, bi);
            a = e; }
    }
    if (KIND == 4) for (int r = 2 * (F.vcu * NWAVES + F.wave); r < MS; r += 2 * F.G * NWAVES) {
        const int bi = NBP + r / TS;
        const float* src = xsp + (size_t)r * D;
        norm_rows<KIND>(F, src, (KIND == 1 || KIND == 3) ? (bf16*)((unsigned char*)HN + (size_t)(MP + r) * D) : HN + (size_t)(MP + r) * D, out_ + O_YS + (size_t)r * D, out_ + O_LS + (size_t)r * NH, 2, bi, part + (size_t)r * D, npart, nullptr);
    }
}
__device__ __forceinline__ void sub_barrier(unsigned* ctr, unsigned n) {
    asm volatile("s_waitcnt vmcnt(0)" ::: "memory"); __syncthreads();
    if (threadIdx.x == 0) {
        __builtin_amdgcn_fence(__ATOMIC_RELEASE, "agent"); asm volatile("s_waitcnt vmcnt(0)" ::: "memory");
        (void)xb_add(ctr, 1u);
        unsigned sp = 0; while (xb_ld(ctr) < n) { __builtin_amdgcn_s_sleep(1); if (++sp > (1u << 22)) break; }
        __builtin_amdgcn_fence(__ATOMIC_ACQUIRE, "agent"); asm volatile("s_waitcnt vmcnt(0)" ::: "memory");
    }
    __syncthreads();
}
template <int KIND> __device__ __forceinline__ void sample_norm_shared(Frame& F, unsigned char* buf, int nblk, unsigned* ctr) {
    unsigned char* const ws_ = WSP(); float* const out_ = OUTP();
    const float* base = KIND == 3 ? (const float*)(ws_ + WS_XSA) : INP(I_XS);
    float* xw = KIND == 1 ? nullptr : KIND == 2 ? (float*)(ws_ + WS_XSA) : (float*)(ws_ + WS_XSB);
    const float* part = (const float*)(ws_ + WS_PART); const int npart = KIND == 1 ? 0 : KIND == 2 ? 5 : 4;
    const int rpw = nblk >= 16 ? 2 : 4, gw = (int)blockIdx.x * NWAVES + F.wave;
    if (gw * rpw < MS) { const int r = gw * rpw, bi = NBP + r / TS;
        bf16* dst = (KIND == 2) ? (bf16*)buf + (size_t)r * D : (bf16*)(buf + (size_t)r * D);
        norm_rows<KIND>(F, base + (size_t)r * D, dst, nullptr, out_ + O_LS + (size_t)r * NH, rpw, bi, part + (size_t)r * D, npart, xw ? xw + (size_t)r * D : nullptr); }
    sub_barrier(ctr, (unsigned)nblk);
}

__device__ __forceinline__ void sample_in_finish(Frame& F, int r) {
    unsigned char* const ws_ = WSP(); float* const out_ = OUTP();
    const int l = (int)(threadIdx.x & 63), j = l & 31, hw = l >> 5;
    const float* P = (const float*)(ws_ + WS_PART) + (size_t)r * NIN + l;
    bf16* A2 = (bf16*)(ws_ + WS_A2) + ((size_t)MP + r) * D; bf16* KB = (bf16*)(ws_ + WS_KB) + ((size_t)MP + r) * DATT; bf16* VB = (bf16*)(ws_ + WS_VB) + ((size_t)MP + r) * DATT; bf16* UB = (bf16*)(ws_ + WS_UB) + ((size_t)MP + r) * DCONV;
    const float gq0 = INP(I_GQ)[j], gq1 = INP(I_GQ)[32 + j], gk0 = INP(I_GK)[j], gk1 = INP(I_GK)[32 + j];
#pragma unroll 1
    for (int pn = 0; pn < NIN / 256; ++pn) {
        float v[4];
#pragma unroll
        for (int q = 0; q < 4; ++q) { const float* p = P + pn * 256 + 64 * q; v[q] = (p[0] + p[(size_t)256 * NIN]) + (p[(size_t)2 * 256 * NIN] + p[(size_t)3 * 256 * NIN]); }
        if (pn < 6) {
            const int sec = pn >> 1, hA = 4 * (pn & 1) + hw;
            if (sec < 2) { float sa = v[0] * v[0] + v[2] * v[2], sb = v[1] * v[1] + v[3] * v[3];
                sa = xsum16(row_sum16(sa)); sb = xsum16(row_sum16(sb));
                const float ra = __builtin_amdgcn_rsqf(sa * (1.0f / 64.0f) + 1e-6f), rb = __builtin_amdgcn_rsqf(sb * (1.0f / 64.0f) + 1e-6f);
                const float g0 = sec == 0 ? gq0 * attn_body::C2 : gk0, g1 = sec == 0 ? gq1 * attn_body::C2 : gk1;
                v[0] *= ra * g0; v[2] *= ra * g1; v[1] *= rb * g0; v[3] *= rb * g1; }
            if (sec == 0) { A2[hA * HD + j] = (bf16)f2bf(v[0]); A2[hA * HD + 32 + j] = (bf16)f2bf(v[2]); A2[(hA + 2) * HD + j] = (bf16)f2bf(v[1]); A2[(hA + 2) * HD + 32 + j] = (bf16)f2bf(v[3]); }
            else { bf16* db = sec == 1 ? KB : VB; float* df = out_ + (sec == 1 ? O_KS : O_VS) + (size_t)r * DATT;
                db[hA * HD + j] = (bf16)f2bf(v[0]); db[hA * HD + 32 + j] = (bf16)f2bf(v[2]); db[(hA + 2) * HD + j] = (bf16)f2bf(v[1]); db[(hA + 2) * HD + 32 + j] = (bf16)f2bf(v[3]);
                df[hA * HD + j] = v[0]; df[hA * HD + 32 + j] = v[2]; df[(hA + 2) * HD + j] = v[1]; df[(hA + 2) * HD + 32 + j] = v[3]; }
        } else {
            const int c0 = 128 * (pn - 6) + l; const float u0 = v[0] * pg8::ep_sigmoid(v[2]), u1 = v[1] * pg8::ep_sigmoid(v[3]);
            UB[c0] = (bf16)f2bf(u0); UB[c0 + 64] = (bf16)f2bf(u1);
            float* d = out_ + O_CS + ((size_t)(r >> 4) * CS + 14 + (r & 15)) * DCONV; d[c0] = u0; d[c0 + 64] = u1;
        }
    }
}

__device__ __forceinline__ void fscan_bh(Frame& F, int bh) {
    unsigned char* const ws_ = WSP(); float* const out_ = OUTP();
    LAS float* wtot = (LAS float*)(F.lds);
    const int b = bh >> 3, h = bh & 7, tid = (int)threadIdx.x, lane = tid & 63;
    const float* lf = out_ + O_LP + (size_t)b * TP * NH + h;
    float* FP = (float*)(ws_ + WS_FP) + (size_t)bh * TP;
    const int t0 = 16 * tid;
    float v[16], run = 0.f;
#pragma unroll
    for (int tt = 0; tt < 16; ++tt) { run += lf[(size_t)(t0 + tt) * NH]; v[tt] = run; }
    float inc = run;
#pragma unroll
    for (int o = 1; o < 64; o <<= 1) { const float n = __shfl_up(inc, o); if (lane >= o) inc += n; }
    if (lane == 63) wtot[F.wave] = inc;
    __syncthreads();
    float pre = inc - run;
    for (int w = 0; w < F.wave; ++w) pre += wtot[w];
#pragma unroll
    for (int q = 0; q < 4; ++q) *(f32x4*)(FP + t0 + 4 * q) = (f32x4){pre + v[4 * q], pre + v[4 * q + 1], pre + v[4 * q + 2], pre + v[4 * q + 3]};
    LAS float* Fend = wtot + 16; LAS float* Fq = Fend + 128;
    if ((tid & 3) == 3) Fend[tid >> 2] = pre + v[15];
    if ((tid & 15) == 0) Fq[tid >> 4] = pre + v[0];
    const float gqm = wave_max(fabsf(INP(I_GQ)[lane])), gkm = wave_max(fabsf(INP(I_GK)[lane]));
    const float skipt = 40.0f + 2.0f * (64.0f * 1.02f * attn_body::C2) * gqm * gkm;
    __syncthreads();
    if (tid < TP / 256) { int lo = 0, hh = 4 * tid; const float fq = Fq[tid];
        while (lo < hh) { const int mid = (lo + hh) >> 1; if ((fq - Fend[mid]) * LOG2E < -skipt) lo = mid + 1; else hh = mid; }
        ((int*)(ws_ + WS_J0))[bh * (TP / 256) + tid] = lo & ~1; }
    __syncthreads();
}

typedef float f32x2 __attribute__((ext_vector_type(2)));
typedef float f32x16 __attribute__((ext_vector_type(16)));
__device__ __forceinline__ f32x2 bfpair(unsigned x) { f32x2 r; r.x = __builtin_bit_cast(float, x << 16); r.y = __builtin_bit_cast(float, x & 0xffff0000u); return r; }
__device__ __forceinline__ void conv_unit(Frame& F, int u) {
    unsigned char* const ws_ = WSP();
    LAS float* ylds = (LAS float*)(F.lds);
    const int tid = threadIdx.x, cp = tid & 255, rh = tid >> 8;
    const bool smp = u >= 512;
    const int b = smp ? u - 512 : u >> 7, t0 = smp ? 0 : 64 * (u & 127), nrows = smp ? TS : 64, tmax = smp ? TS : TP;
    const int th0 = t0 + 32 * rh;
    const size_t rowbase = smp ? (size_t)MP + (size_t)b * TS : (size_t)b * TP;
    const unsigned* UBp = (const unsigned*)((const bf16*)(ws_ + WS_UB) + rowbase * DCONV) + cp;
    const float* st = INP(I_SCONV) + (size_t)b * CS * DCONV + 2 * cp;
    f32x2 w[CW]; const float* cwp = INP(I_CONVW);
#pragma unroll
    for (int j = 0; j < CW; ++j) w[j] = *(const f32x2*)(cwp + j * DCONV + 2 * cp);
    const f32x2 cb = *(const f32x2*)(INP(I_CONVB) + 2 * cp);
    f32x2 win[32];
#pragma unroll
    for (int s = 0; s < 32; ++s) { const int t = th0 - 32 + s; f32x2 v = (f32x2){0.f, 0.f};
        if (t >= 0) { if (t < tmax) v = bfpair(UBp[(size_t)t * 256]); } else if (smp && t >= -CS) v = *(const f32x2*)(st + (size_t)(CS + t) * DCONV);
        win[s] = v; }
    unsigned nw[32];
#pragma unroll
    for (int s = 0; s < 32; ++s) nw[s] = (th0 + s) < tmax ? UBp[(size_t)(th0 + s) * 256] : 0u;
#pragma unroll
    for (int s = 0; s < 32; ++s) { win[s] = bfpair(nw[s]); f32x2 a = cb;
#pragma unroll
        for (int j = 0; j < CW; ++j) a += w[j] * win[(s - 30 + j) & 31];
        *(LAS f32x2*)(ylds + (32 * rh + s) * DCONV + 2 * cp) = a; }
    __syncthreads();
    { const int lane = ((int)(threadIdx.x & 63)); const float* lng = INP(I_LNG); const float* lnb = INP(I_LNB); f32x4 g0 = *(const f32x4*)(lng + 8 * lane), g1 = *(const f32x4*)(lng + 8 * lane + 4), b0 = *(const f32x4*)(lnb + 8 * lane), b1 = *(const f32x4*)(lnb + 8 * lane + 4);
        bf16* A2 = (bf16*)(ws_ + WS_A2);
        for (int r = F.wave; r < nrows; r += NWAVES) {
            f32x4 y0 = *(const LAS f32x4*)(ylds + r * DCONV + 8 * lane), y1 = *(const LAS f32x4*)(ylds + r * DCONV + 8 * lane + 4);
            const float mu = wave_sum((y0[0] + y0[1]) + (y0[2] + y0[3]) + (y1[0] + y1[1]) + (y1[2] + y1[3])) * (1.0f / DCONV);
            y0 = y0 - mu; y1 = y1 - mu;
            const float var = wave_sum((y0[0] * y0[0] + y0[1] * y0[1]) + (y0[2] * y0[2] + y0[3] * y0[3]) + (y1[0] * y1[0] + y1[1] * y1[1]) + (y1[2] * y1[2] + y1[3] * y1[3])) * (1.0f / DCONV);
            const float rs = 1.0f / sqrtf(var + EPS);
            y0 = y0 * rs * g0 + b0; y1 = y1 * rs * g1 + b1;
            float o[8];
#pragma unroll
            for (int i = 0; i < 4; ++i) { o[i] = pg8::ep_silu(y0[i]); o[4 + i] = pg8::ep_silu(y1[i]); }
            v4u pk; pk.x = pk2(o[0], o[1]); pk.y = pk2(o[2], o[3]); pk.z = pk2(o[4], o[5]); pk.w = pk2(o[6], o[7]);
            *(GAS v4u*)(A2 + (rowbase + t0 + r) * D + DATT + 8 * lane) = pk;
        } }
    __syncthreads();
}

__device__ __forceinline__ void conv_run(Frame& F, int u0, int ustep, int uend) {
    if (u0 >= uend) return;
    unsigned char* const ws_ = WSP();
    LAS float* ylds = (LAS float*)(F.lds);
    const int tid = threadIdx.x, cp = tid & 255, rh = tid >> 8, lane = tid & 63;
    f32x2 w[CW]; const float* cwp = INP(I_CONVW);
#pragma unroll
    for (int j = 0; j < CW; ++j) w[j] = *(const f32x2*)(cwp + j * DCONV + 2 * cp);
    const f32x2 cb = *(const f32x2*)(INP(I_CONVB) + 2 * cp);
    const float* lng = INP(I_LNG); const float* lnb = INP(I_LNB);
    const f32x4 g0 = *(const f32x4*)(lng + 8 * lane), g1 = *(const f32x4*)(lng + 8 * lane + 4), b0 = *(const f32x4*)(lnb + 8 * lane), b1 = *(const f32x4*)(lnb + 8 * lane + 4);
    const unsigned* UB0 = (const unsigned*)(ws_ + WS_UB) + cp;
    bf16* A2 = (bf16*)(ws_ + WS_A2);
    unsigned pre[64];
#define CV_LOAD(u_) do { const int b_ = (u_) >> 7, th_ = 64 * ((u_) & 127) + 32 * rh - 32; const unsigned* p_ = UB0 + (size_t)b_ * TP * 256; \
        _Pragma("unroll") for (int s = 0; s < 64; ++s) { const int t_ = th_ + s; const unsigned v_ = p_[(size_t)(t_ < 0 ? 0 : t_) * 256]; pre[s] = t_ < 0 ? 0u : v_; } } while (0)
    CV_LOAD(u0);
#pragma unroll 1
    for (int u = u0; u < uend; u += ustep) {
        f32x2 win[32];
#pragma unroll
        for (int s = 0; s < 32; ++s) win[s] = bfpair(pre[s]);
#pragma unroll
        for (int s = 0; s < 32; ++s) { win[s] = bfpair(pre[32 + s]); f32x2 a = cb;
#pragma unroll
            for (int j = 0; j < CW; ++j) a += w[j] * win[(s - 30 + j) & 31];
            *(LAS f32x2*)(ylds + (32 * rh + s) * DCONV + 2 * cp) = a; }
        __syncthreads();
        if (u + ustep < uend) CV_LOAD(u + ustep);
        { const size_t row0 = (size_t)(u >> 7) * TP + 64 * (u & 127);
#pragma unroll 1
            for (int r = F.wave; r < 64; r += 2 * NWAVES) {
                f32x4 y[2][2]; float mu[2], var[2];
#pragma unroll
                for (int q = 0; q < 2; ++q) { y[q][0] = *(const LAS f32x4*)(ylds + (r + 8 * q) * DCONV + 8 * lane); y[q][1] = *(const LAS f32x4*)(ylds + (r + 8 * q) * DCONV + 8 * lane + 4);
                    mu[q] = (y[q][0][0] + y[q][0][1]) + (y[q][0][2] + y[q][0][3]) + (y[q][1][0] + y[q][1][1]) + (y[q][1][2] + y[q][1][3]); }
                mu[0] = wave_sum(mu[0]); mu[1] = wave_sum(mu[1]);
#pragma unroll
                for (int q = 0; q < 2; ++q) { mu[q] *= (1.0f / DCONV); y[q][0] = y[q][0] - mu[q]; y[q][1] = y[q][1] - mu[q];
                    var[q] = (y[q][0][0] * y[q][0][0] + y[q][0][1] * y[q][0][1]) + (y[q][0][2] * y[q][0][2] + y[q][0][3] * y[q][0][3]) + (y[q][1][0] * y[q][1][0] + y[q][1][1] * y[q][1][1]) + (y[q][1][2] * y[q][1][2] + y[q][1][3] * y[q][1][3]); }
                var[0] = wave_sum(var[0]); var[1] = wave_sum(var[1]);
#pragma unroll
                for (int q = 0; q < 2; ++q) { const float rs = 1.0f / sqrtf(var[q] * (1.0f / DCONV) + EPS);
                    const f32x4 z0 = y[q][0] * rs * g0 + b0, z1 = y[q][1] * rs * g1 + b1;
                    v4u pk; pk.x = pk2(pg8::ep_silu(z0[0]), pg8::ep_silu(z0[1])); pk.y = pk2(pg8::ep_silu(z0[2]), pg8::ep_silu(z0[3])); pk.z = pk2(pg8::ep_silu(z1[0]), pg8::ep_silu(z1[1])); pk.w = pk2(pg8::ep_silu(z1[2]), pg8::ep_silu(z1[3]));
                    *(GAS v4u*)(A2 + (row0 + r + 8 * q) * D + DATT + 8 * lane) = pk; }
            } }
        __syncthreads();
    }
#undef CV_LOAD
}

__device__ __forceinline__ bf16x8 pack8(f32x4 a, f32x4 b) { v4u w; w.x = pg8::cvt_pk_bf16(a[0], a[1]); w.y = pg8::cvt_pk_bf16(a[2], a[3]); w.z = pg8::cvt_pk_bf16(b[0], b[1]); w.w = pg8::cvt_pk_bf16(b[2], b[3]); return __builtin_bit_cast(bf16x8, w); }
__device__ __forceinline__ void sattn_unit(Frame& F, int b, int h, bf16* OB) {
    unsigned char* const ws_ = WSP(); float* const out_ = OUTP();
    LAS float* bias = (LAS float*)(F.lds);
    LAS float* wtot = bias + 2080;
    LAS float* wsf = wtot + 16;
    LAS float* mw = wsf + 128;
    LAS float* lw = mw + 128;
    LAS float* ow = lw + 128;
    const int tid = threadIdx.x, lane = tid & 63, r32 = lane & 31, hi = lane >> 5, wave = F.wave;
    const float* kc = INP(I_CK) + ((size_t)b * PAST * NH + h) * HD; const float* vc = INP(I_CV) + ((size_t)b * PAST * NH + h) * HD;
    const float* kn = out_ + O_KS + ((size_t)b * TS * NH + h) * HD; const float* vn = out_ + O_VS + ((size_t)b * TS * NH + h) * HD;
    const int nit = wave == 0 ? 9 : 8;
    f32x4 KrA[8], KrB[8], Vq[8];
    LAS char* const vt = (LAS char*)(ow + 8192) + wave * 4096;
    const attn_body::lds_cptr vtr0 = (attn_body::lds_cptr)vt + ((lane >> 4) & 1) * 32 + (lane & 3) * 8 + (4 * hi + ((lane & 15) >> 2)) * 64;
#define SA_LOADK(Kr, it) do { const bool nw_ = (it) == 8; const int kb_ = nw_ ? 0 : 256 * wave + 32 * (it); \
        const float* kp_ = (nw_ ? kn : kc) + (size_t)(kb_ + (nw_ ? (r32 & 15) : r32)) * (NH * HD) + 8 * hi; \
        _Pragma("unroll") for (int d0 = 0; d0 < 4; ++d0) { Kr[2 * d0] = __builtin_nontemporal_load((const f32x4*)(kp_ + 16 * d0)); Kr[2 * d0 + 1] = __builtin_nontemporal_load((const f32x4*)(kp_ + 16 * d0 + 4)); } } while (0)
#define SA_LOADV(it) do { const bool nw_ = (it) == 8; const int kb_ = nw_ ? 0 : 256 * wave + 32 * (it); \
        const float* vp_ = (nw_ ? vn : vc) + (size_t)kb_ * (NH * HD) + 4 * (lane & 15); \
        _Pragma("unroll") for (int i_ = 0; i_ < 8; ++i_) { int key_ = 4 * i_ + (lane >> 4); if (nw_) key_ &= 15; Vq[i_] = __builtin_nontemporal_load((const f32x4*)(vp_ + (size_t)key_ * (NH * HD))); } } while (0)
    SA_LOADK(KrA, 0); SA_LOADV(0); SA_LOADK(KrB, 1);
    { const float* clf = INP(I_CLF) + (size_t)b * PAST * NH + h; float v[4], run = 0.f;
#pragma unroll
        for (int i = 0; i < 4; ++i) { run += clf[(size_t)(4 * tid + i) * NH]; v[i] = run; }
        float inc = run;
#pragma unroll
        for (int o = 1; o < 64; o <<= 1) { const float n = __shfl_up(inc, o); if (lane >= o) inc += n; }
        if (lane == 63) wtot[wave] = inc;
        __syncthreads();
        float pre = inc - run, total = 0.f;
        for (int w = 0; w < NWAVES; ++w) { const float x = wtot[w]; if (w < wave) pre += x; total += x; }
#pragma unroll
        for (int i = 0; i < 4; ++i) bias[4 * tid + i] = (total - (pre + v[i])) * LOG2E;
        if (tid == 0) { const float* lfn = out_ + O_LS + (size_t)b * TS * NH + h; float r2 = 0.f; for (int i = 0; i < TS; ++i) { r2 += lfn[i * NH]; bias[PAST + i] = -r2 * LOG2E; } }
        if (tid >= 16 && tid < 32) bias[PAST + tid] = 0.f;
    }
    __syncthreads();
    bf16x8 qf[4];
    { const bf16* qp = (const bf16*)(ws_ + WS_A2) + ((size_t)MP + b * TS + (r32 & 15)) * D + h * HD + 8 * hi;
#pragma unroll
        for (int d0 = 0; d0 < 4; ++d0) { const bf16x8 v = *(const bf16x8*)(qp + 16 * d0); qf[d0] = r32 < 16 ? v : (bf16x8){0, 0, 0, 0, 0, 0, 0, 0}; } }
    float m = -INFINITY, l = 0.f; f32x16 o[2]; o[0] = f32x16{}; o[1] = f32x16{};
#define SA_BODY(Kr, it) do { \
        bf16x8 kf[4], vf[4]; \
        _Pragma("unroll") \
        for (int d0 = 0; d0 < 4; ++d0) kf[d0] = pack8(Kr[2 * d0], Kr[2 * d0 + 1]); \
        _Pragma("unroll") \
        for (int i = 0; i < 8; ++i) { typedef unsigned u32x2v __attribute__((ext_vector_type(2))); \
            *(LAS u32x2v*)(vt + ((lane & 15) >> 3) * 2048 + (4 * i + (lane >> 4)) * 64 + (lane & 7) * 8) = (u32x2v){pg8::cvt_pk_bf16(Vq[i][0], Vq[i][1]), pg8::cvt_pk_bf16(Vq[i][2], Vq[i][3])}; } \
        asm volatile("s_waitcnt lgkmcnt(0)" ::: "memory"); \
        _Pragma("unroll") \
        for (int q = 0; q < 4; ++q) { const attn_body::s16x4 lo_ = attn_body::vtr(vtr0 + (q & 1) * 2048 + (q >> 1) * 1024), hi_ = attn_body::vtr(vtr0 + (q & 1) * 2048 + (q >> 1) * 1024 + 512); \
            vf[q] = (bf16x8){lo_[0], lo_[1], lo_[2], lo_[3], hi_[0], hi_[1], hi_[2], hi_[3]}; } \
        if (it + 1 < nit) SA_LOADV(it + 1); if (it + 2 < nit) SA_LOADK(Kr, it + 2); \
        const bool nwk = it == 8; const int bidx = nwk ? PAST : 256 * wave + 32 * it; \
        f32x16 S; \
        _Pragma("unroll") \
        for (int g = 0; g < 4; ++g) { const f32x4 x = *(const LAS f32x4*)(bias + bidx + 4 * hi + 8 * g); \
        _Pragma("unroll") \
            for (int i = 0; i < 4; ++i) S[4 * g + i] = x[i]; } \
        _Pragma("unroll") \
        for (int d0 = 0; d0 < 4; ++d0) S = __builtin_amdgcn_mfma_f32_32x32x16_bf16(kf[d0], qf[d0], S, 0, 0, 0); \
        if (nwk) { \
        _Pragma("unroll") \
            for (int r = 0; r < 16; ++r) { const int key = (r & 3) + 8 * (r >> 2) + 4 * hi; if (key > r32 || key >= TS) S[r] = -INFINITY; } } \
        float rm = S[0]; \
        _Pragma("unroll") \
        for (int r = 1; r < 16; ++r) rm = fmaxf(rm, S[r]); \
        rm = xmax32(rm); \
        const float mn = fmaxf(m, rm), al = __builtin_amdgcn_exp2f(m - mn); m = mn; \
        float rs = 0.f; \
        _Pragma("unroll") \
        for (int r = 0; r < 16; ++r) { S[r] = __builtin_amdgcn_exp2f(S[r] - mn); rs += S[r]; } \
        l = l * al + rs; \
        if (hi == 0 && r32 < 16) wsf[wave * 16 + r32] = al; \
        asm volatile("s_waitcnt lgkmcnt(0)" ::: "memory"); \
        const f32x4 a0 = *(const LAS f32x4*)(wsf + wave * 16 + 4 * hi), a1 = *(const LAS f32x4*)(wsf + wave * 16 + 8 + 4 * hi); \
        _Pragma("unroll") \
        for (int dh = 0; dh < 2; ++dh) \
        _Pragma("unroll") \
            for (int i = 0; i < 4; ++i) { o[dh][i] *= a0[i]; o[dh][4 + i] *= a1[i]; } \
        const bf16x8 pw0 = pack8((f32x4){S[0], S[1], S[2], S[3]}, (f32x4){S[4], S[5], S[6], S[7]}), pw1 = pack8((f32x4){S[8], S[9], S[10], S[11]}, (f32x4){S[12], S[13], S[14], S[15]}); \
        _Pragma("unroll") \
        for (int dh = 0; dh < 2; ++dh) { o[dh] = __builtin_amdgcn_mfma_f32_32x32x16_bf16(pw0, vf[dh], o[dh], 0, 0, 0); o[dh] = __builtin_amdgcn_mfma_f32_32x32x16_bf16(pw1, vf[2 + dh], o[dh], 0, 0, 0); } \
    } while (0)
#pragma unroll 1
    for (int it2 = 0; it2 < nit; it2 += 2) { SA_BODY(KrA, (it2)); if (it2 + 1 < nit) SA_BODY(KrB, (it2 + 1)); }
#undef SA_BODY
#undef SA_LOADK
#undef SA_LOADV
    l = xsum32(l);
    if (hi == 0 && r32 < 16) { mw[wave * 16 + r32] = m; lw[wave * 16 + r32] = l; }
#pragma unroll
    for (int dh = 0; dh < 2; ++dh)
#pragma unroll
        for (int r = 0; r < 8; ++r) ow[(wave * 16 + (r & 3) + 8 * (r >> 2) + 4 * hi) * 64 + 32 * dh + r32] = o[dh][r];
    __syncthreads();
    for (int e = tid; e < TS * HD; e += NWAVES * 64) { const int q = e >> 6; float M = -INFINITY;
#pragma unroll
        for (int w = 0; w < NWAVES; ++w) M = fmaxf(M, mw[w * 16 + q]);
        float num = 0.f, den = 0.f;
#pragma unroll
        for (int w = 0; w < NWAVES; ++w) { const float f = __builtin_amdgcn_exp2f(mw[w * 16 + q] - M); num += ow[w * 1024 + e] * f; den += lw[w * 16 + q] * f; }
        OB[((size_t)MP + b * TS + q) * D + h * HD + (e & 63)] = (bf16)f2bf(num / den); }
    __syncthreads();
}
struct AttnQueue {
    unsigned* ctr; const unsigned* flag; const unsigned short* order; volatile LAS unsigned* slot;
    __device__ __forceinline__ bool next(int, attn_body::AttnUnit& u) const {
        if (threadIdx.x == 0) {
            if (slot[2] == 0u) { unsigned sp = 0; while (__hip_atomic_load(flag, __ATOMIC_RELAXED, __HIP_MEMORY_SCOPE_AGENT) == 0u) { __builtin_amdgcn_s_sleep(2); if (++sp > (1u << 22)) break; }
                __builtin_amdgcn_fence(__ATOMIC_ACQUIRE, "agent"); slot[2] = 1u; }
            const unsigned k = __hip_atomic_fetch_add(ctr, 1u, __ATOMIC_RELAXED, __HIP_MEMORY_SCOPE_AGENT);
            slot[0] = k < (unsigned)(attn_body::BATCH * attn_body::NHEAD * attn_body::NQB) ? (unsigned)__hip_atomic_load(order + k, __ATOMIC_RELAXED, __HIP_MEMORY_SCOPE_AGENT) : 0xffffffffu; }
        __syncthreads();
        const unsigned k = (unsigned)__builtin_amdgcn_readfirstlane((int)slot[0]);
        __syncthreads();
        u.qb = (int)(k & 31u); u.bh = (int)((k >> 5) & 31u);
        return k != 0xffffffffu;
    }
    __device__ __forceinline__ void a_ready(const attn_body::AttnUnit&) const {}
    __device__ __forceinline__ void done(const attn_body::AttnUnit&) const {}
};
__device__ __forceinline__ void attn_sort(Frame& F, unsigned* flag) {
    unsigned char* const ws_ = WSP();
    LAS unsigned* hist = (LAS unsigned*)(F.lds);
    const int tid = (int)threadIdx.x; const int* j0tab = (const int*)(ws_ + WS_J0); unsigned short* order = (unsigned short*)(ws_ + WS_J0 + 8192);
    if (__builtin_amdgcn_readfirstlane((int)__hip_atomic_load(flag, __ATOMIC_RELAXED, __HIP_MEMORY_SCOPE_AGENT)) != 0) return;
    if (tid < 64) hist[tid] = 0u;
    __syncthreads();
    int key[2];
#pragma unroll
    for (int q = 0; q < 2; ++q) { const int u = 2 * tid + q; const int nt = 4 * (u & 31) + 4 - j0tab[u]; key[q] = 64 - (nt >> 1); __hip_atomic_fetch_add(hist + key[q], 1u, __ATOMIC_RELAXED, __HIP_MEMORY_SCOPE_WORKGROUP); }
    __syncthreads();
    if (tid == 0) { unsigned run = 0; for (int b = 0; b < 64; ++b) { const unsigned c = hist[b]; hist[b] = run; run += c; } }
    __syncthreads();
#pragma unroll
    for (int q = 0; q < 2; ++q) { const unsigned pos = __hip_atomic_fetch_add(hist + key[q], 1u, __ATOMIC_RELAXED, __HIP_MEMORY_SCOPE_WORKGROUP); order[pos] = (unsigned short)(2 * tid + q); }
    asm volatile("s_waitcnt vmcnt(0)" ::: "memory"); __syncthreads();
    if (tid == 0) { __builtin_amdgcn_fence(__ATOMIC_RELEASE, "agent"); asm volatile("s_waitcnt vmcnt(0)" ::: "memory"); __hip_atomic_store(flag, 1u, __ATOMIC_RELAXED, __HIP_MEMORY_SCOPE_AGENT); }
    __syncthreads();
}

struct Args { const float* in[N_IN]; float* out; unsigned char* ws; int ph_lo, ph_hi, li, pad; };
__global__ void __launch_bounds__(NWAVES * 64, 2) fox_fwd(Args args) {
    extern __shared__ __attribute__((aligned(16))) unsigned char lds[];
    Frame F;
    F.lds = (LAS unsigned char*)lds;
    F.MISC = (volatile LAS unsigned*)(F.lds + MISC_OFF);
    F.wave = __builtin_amdgcn_readfirstlane((int)threadIdx.x >> 6);
    F.G = gridDim.x; { const int bx = blockIdx.x; F.vcu = (F.G % 8 == 0) ? (bx % 8) * (F.G / 8) + bx / 8 : bx; }
    for (int u = ((int)threadIdx.x); u < (LDS_BYTES - LDSCTL_OFF) / 4; u += NWAVES * 64) ((LAS unsigned*)(F.lds + LDSCTL_OFF))[u] = 0u;
    __syncthreads();
    if (N_LAUNCHES == 1) (void)xcd_barrier_post((unsigned*)(WSP() + WS_CTL) + CW_BAR, F.MISC + 8);

#define X ((bf16*)(WSP() + WS_X))
#define MOD ((float*)(WSP() + WS_MOD))
#define HN ((bf16*)(WSP() + WS_HN))
#define HID ((bf16*)(WSP() + WS_HID))
#define A2 ((bf16*)(WSP() + WS_A2))
    const int lo = args.ph_lo, hi = args.ph_hi;
#define IN(k) (lo <= (k) && (k) < hi)
#ifndef EXTRA_BAR_AT
#define EXTRA_BAR_AT 99
#endif
#ifndef EXTRA_BAR
#define EXTRA_BAR 0
#endif
#define SEAM(k) do { if (IN((k) + 1)) { for (int xb_ = 0; xb_ < ((k) == EXTRA_BAR_AT ? EXTRA_BAR : 0); ++xb_) { XcdBarrier bar0; bar0.bar = (unsigned*)(WSP() + WS_CTL) + CW_BAR; bar0.x = xb_xcc_id(); bar0.st = F.MISC + 8; xcd_barrier(bar0); } XcdBarrier bar; bar.bar = (unsigned*)(WSP() + WS_CTL) + CW_BAR; bar.x = xb_xcc_id(); bar.st = F.MISC + 8; xcd_barrier(bar); } } while (0)
#ifndef UP_ALIGN
#define UP_ALIGN true
#endif
#ifndef UP_SP2
#define UP_SP2 true
#endif
#define GEMM_UP(WOFF) do { pg8::Gemm g{HN, (const bf16*)(WSP() + (WOFF)), M, NUP, D}; pg8::StaticOrder S; S.init(MP, NUP, F.G, (int)blockIdx.x, D / 128); pg8::EpiSwiGLU E{(unsigned char*)HID, 1.0f / 64.0f}; \
        pg8::gemm_phase<pg8::EpiSwiGLU, pg8::StaticOrder, UP_ALIGN, UP_SP2, true>(F.lds + RING_OFF, g, S, E); } while (0)
#define SAMPLE_UP(KIND_, WOFF) do { if ((int)blockIdx.x < NUP / 256) { unsigned char* priv_ = WSP() + WS_SPRIV; sample_norm_shared<KIND_>(F, priv_, NUP / 256, (unsigned*)(WSP() + WS_CTL) + CW_SUB + 64 * (KIND_) + (args.pad == 55 ? 256 : 0)); \
        pg8::Gemm g{(const bf16*)(priv_ - (size_t)MP * D), (const bf16*)(WSP() + (WOFF)), M, NUP, D}; pg8::OneUnit S{MP / 256, (int)blockIdx.x, D / 128}; pg8::EpiSwiGLU E{(unsigned char*)HID, 1.0f / 64.0f}; \
        pg8::gemm_phase<pg8::EpiSwiGLU, pg8::OneUnit, true, true, true>(F.lds + RING_OFF, g, S, E); } } while (0)
#define GEMM_RES(FP8_, BBF_, A_, WOFF, K_, NTK_, BP, CHUNK, COEF) do { pg8::Gemm g{(A_), (const bf16*)(WSP() + (WOFF)), M, D, (K_)}; pg8::SplitOrder S; S.init(MP, D, F.G, (int)blockIdx.x, (NTK_), 4); \
        pg8::EpiResid<BBF_> E{(const void*)(BP), (args.pad == 77 ? HN : X), MOD + (CHUNK) * D, (COEF), (float*)(WSP() + WS_PART)};     \
        pg8::gemm_phase<pg8::EpiResid<BBF_>, pg8::SplitOrder, true, true, FP8_>(F.lds + RING_OFF, g, S, E); } while (0)
    if (IN(0)) { p0_prologue(F); SEAM(0); }
    if (IN(1)) { SAMPLE_UP(1, WS_WUP1); norm_phase<1>(F, NUP / 256); SEAM(1); }
#ifdef PROBE_NULLEPI
    if (IN(2) && args.pad == 99) { pg8::Gemm g{HN, (const bf16*)(WSP() + WS_WUP1), M, NUP, D}; pg8::StaticOrder S; S.init(M, NUP, F.G, (int)blockIdx.x, D / 128); pg8::EpiNull E{(float*)(WSP() + WS_PART)};
        pg8::gemm_phase<pg8::EpiNull, pg8::StaticOrder, true, true, true>(F.lds + RING_OFF, g, S, E); }
    else
#endif
    if (IN(2)) { GEMM_UP(WS_WUP1); SEAM(2); }
    if (IN(3)) { GEMM_RES(true, false, HID, WS_WDN1, FF, FF / 128, INP(I_XP), 2, 0.5f / 64.0f); SEAM(3); }
#ifndef DIS_N2
    if (IN(4)) {
        constexpr int NPW = (NIN / 256) * 4;
        if ((int)blockIdx.x < NPW) { unsigned char* priv_ = WSP() + WS_SPRIV; const unsigned cb_ = (args.pad == 55 ? 256u : 0u);
            sample_norm_shared<2>(F, priv_, NPW, (unsigned*)(WSP() + WS_CTL) + CW_SUB + 64 * 2 + cb_);
            pg8::Gemm g{(const bf16*)priv_ - (size_t)MP * D, (const bf16*)(WSP() + WS_WIN), M, NIN, D}; pg8::PieceOrder S{MP / 256, NIN / 256, 4, 4, (int)blockIdx.x};
            pg8::EpiPart E{(float*)(WSP() + WS_PART), NIN};
            pg8::gemm_phase<pg8::EpiPart, pg8::PieceOrder, true, true>(F.lds + RING_OFF, g, S, E);
            sub_barrier((unsigned*)(WSP() + WS_CTL) + CW_SUB + 64 * 5 + cb_, NPW);
            { const int r = (int)blockIdx.x * NWAVES + F.wave; if (r < MS) sample_in_finish(F, r); } }
        norm_phase<2>(F, NPW); SEAM(4); }
#endif
#ifdef PROBE_NULLIN
    if (IN(5) && args.pad == 98) { pg8::Gemm g{HN, (const bf16*)(WSP() + WS_WIN), M, NIN, D}; pg8::StaticOrder S; S.init(MP, NIN, F.G, (int)blockIdx.x, D / 64); pg8::EpiNull E{(float*)(WSP() + WS_PART)};
        pg8::gemm_phase<pg8::EpiNull, pg8::StaticOrder, true, true>(F.lds + RING_OFF, g, S, E); }
    else
#endif
    if (IN(5)) {
        for (int bh = blockIdx.x; bh < NBP * NH; bh += F.G) fscan_bh(F, bh);
        pg8::Gemm g{HN, (const bf16*)(WSP() + WS_WIN), M, NIN, D}; pg8::StaticOrder S; S.init(MP, NIN, F.G, (int)blockIdx.x, D / 64);
        pg8::EpiIn E{A2, (bf16*)(WSP() + WS_KB), (bf16*)(WSP() + WS_VB), (bf16*)(WSP() + WS_UB), OUTP(), INP(I_GQ), INP(I_GK), attn_body::C2, O_KP, O_VP, O_KS, O_VS, O_CP, O_CS, (args.pad >= 90 && args.pad <= 93) ? args.pad - 90 : 0};
        pg8::gemm_phase<pg8::EpiIn, pg8::StaticOrder, true, true>(F.lds + RING_OFF, g, S, E);
        SEAM(5);
    }
    if (IN(6)) {
        const int half = F.G / 2; const int sub = args.pad;
        bf16* const OB = (sub & 8) ? HN : A2;
        if ((int)blockIdx.x < half) { if (sub & 1) for (int u = blockIdx.x; u < NBS * NH; u += half) sattn_unit(F, u >> 3, u & 7, OB);
            if ((sub & 2) && (blockIdx.x & 1)) conv_run(F, (int)(blockIdx.x >> 1), half / 2, 64); }
        else { if ((sub & 4) && (int)blockIdx.x == F.G - 1) attn_sort(F, (unsigned*)(WSP() + WS_CTL) + CW_AQ + 128);
            if (sub & 2) { conv_run(F, 64 + (int)blockIdx.x - half, F.G - half, 512); for (int u = 512 + (int)blockIdx.x - half; u < 512 + NBS; u += F.G - half) conv_unit(F, u); } }
        if (sub & 4) {
        const attn_body::AttnTensors AT{(const attn_body::bf16*)A2, (const attn_body::bf16*)(WSP() + WS_KB), (const attn_body::bf16*)(WSP() + WS_VB), (attn_body::bf16*)OB, (const float*)(WSP() + WS_FP), (const int*)(WSP() + WS_J0), (64.0f * 1.02f * attn_body::C2) * wave_max(fabsf(INP(I_GQ)[threadIdx.x & 63])) * wave_max(fabsf(INP(I_GK)[threadIdx.x & 63]))};
        const AttnQueue S{(unsigned*)(WSP() + WS_CTL) + CW_AQ + 64 * (sub >> 4), (const unsigned*)(WSP() + WS_CTL) + CW_AQ + 128, (const unsigned short*)(WSP() + WS_J0 + 8192), F.MISC + 16};
#ifndef ATT_THRL
#define ATT_THRL 8
#endif
        attn_body::attn_phase<AttnQueue, ATT_THRL>((char*)lds + RING_OFF, AT, S);
        }
        SEAM(6);
    }
    if (IN(7)) { GEMM_RES(false, true, A2, WS_WOUT, D, D / 64, X, 5, 1.0f); SEAM(7); }
    if (IN(8)) { SAMPLE_UP(3, WS_WUP2); norm_phase<3>(F, NUP / 256); SEAM(8); }
    if (IN(9)) { GEMM_UP(WS_WUP2); SEAM(9); }
    if (IN(10)) { GEMM_RES(true, true, HID, WS_WDN2, FF, FF / 128, X, 8, 0.5f / 64.0f); SEAM(10); }
    if (IN(11)) { norm_phase<4>(F, 0); }
#undef IN
#undef SEAM
#undef X
#undef MOD
#undef HN
#undef HID
#undef A2
}

extern "C" void kernel_launch(void* const* d_in, const int* in_sizes, int n_in, void* d_out, int out_size, void* d_ws, size_t ws_size, hipStream_t stream) {
    static int grid = 0;
    if (grid == 0) {
        if (n_in != N_IN || in_sizes[0] != MP * D || (size_t)out_size != O_END || ws_size < WS_END) { fprintf(stderr, "kernel_launch: unexpected shapes (n_in %d, in0 %d, out %d, ws %zu); nothing launched\n", n_in, n_in > 0 ? in_sizes[0] : -1, out_size, ws_size); grid = -1; return; }
        int dev = 0, cus = 0, per_cu = 0;
        if (hipGetDevice(&dev) != hipSuccess || hipDeviceGetAttribute(&cus, hipDeviceAttributeMultiprocessorCount, dev) != hipSuccess) { fprintf(stderr, "kernel_launch: device query failed\n"); grid = -1; return; }
        if (hipFuncSetAttribute((const void*)fox_fwd, hipFuncAttributeMaxDynamicSharedMemorySize, LDS_BYTES) != hipSuccess) { fprintf(stderr, "kernel_launch: hipFuncSetAttribute failed\n"); grid = -1; return; }
        if (hipOccupancyMaxActiveBlocksPerMultiprocessor(&per_cu, (const void*)fox_fwd, NWAVES * 64, LDS_BYTES) != hipSuccess || per_cu < 1) { fprintf(stderr, "kernel_launch: occupancy query reports %d workgroups per CU; nothing launched\n", per_cu); (void)hipGetLastError(); grid = -1; return; }
        grid = cus;
    }
    if (grid < 0) return;
    if (hipMemsetAsync((char*)d_ws + WS_CTL, 0, CTL_ZERO_BYTES, stream) != hipSuccess) { fprintf(stderr, "kernel_launch: memset failed\n"); return; }
    Args a{};
    for (int i = 0; i < N_IN; ++i) a.in[i] = (const float*)d_in[i];
    a.out = (float*)d_out; a.ws = (unsigned char*)d_ws; a.pad = 7;
    if (N_LAUNCHES == 1) {
        a.ph_lo = 0; a.ph_hi = N_PHASES; a.li = 0;
        void* kargs[] = {&a};
        const hipError_t le = hipLaunchCooperativeKernel((const void*)fox_fwd, dim3(grid), dim3(NWAVES * 64), kargs, LDS_BYTES, stream);
        if (le != hipSuccess) fprintf(stderr, "kernel_launch: cooperative launch failed: %s (grid %d)\n", hipGetErrorName(le), grid);
    } else {
        for (int li = 0; li < N_PHASES; ++li) { a.ph_lo = li; a.ph_hi = li + 1; a.li = li;
            hipLaunchKernelGGL(fox_fwd, dim3(grid), dim3(NWAVES * 64), LDS_BYTES, stream, a);
#ifdef PROBE_DUP
            if ((PROBE_DUP >> li) & 1) hipLaunchKernelGGL(fox_fwd, dim3(grid), dim3(NWAVES * 64), LDS_BYTES, stream, a);
#endif
#ifdef PROBE_NULLEPI
            if (li == 2) { Args p = a; p.pad = 99; hipLaunchKernelGGL(fox_fwd, dim3(grid), dim3(NWAVES * 64), LDS_BYTES, stream, p); }
#endif
#ifdef PROBE_DUPN
            if ((PROBE_DUPN >> li) & 1) { Args p = a; p.pad = 55; hipLaunchKernelGGL(fox_fwd, dim3(grid), dim3(NWAVES * 64), LDS_BYTES, stream, p); }
#endif
#ifdef PROBE_NULLIN
            if (li == 5) { Args p = a; p.pad = 98; hipLaunchKernelGGL(fox_fwd, dim3(grid), dim3(NWAVES * 64), LDS_BYTES, stream, p); }
#endif
#ifdef PROBE_INV
            if (li == 5) { Args p = a; p.pad = 90 + PROBE_INV; hipLaunchKernelGGL(fox_fwd, dim3(grid), dim3(NWAVES * 64), LDS_BYTES, stream, p); }
#endif
#ifdef PROBE_P7
            if (li == 6) { Args p = a; p.ph_lo = 7; p.ph_hi = 8; p.pad = 77; hipLaunchKernelGGL(fox_fwd, dim3(grid), dim3(NWAVES * 64), LDS_BYTES, stream, p); }
#endif
#ifdef PROBE_SUB6
            if (li == 5) { Args p = a; p.ph_lo = 6; p.ph_hi = 7; p.pad = PROBE_SUB6 | 16; hipLaunchKernelGGL(fox_fwd, dim3(grid), dim3(NWAVES * 64), LDS_BYTES, stream, p); }
#endif
            const hipError_t le = hipPeekAtLastError(); if (le != hipSuccess) { fprintf(stderr, "kernel_launch: launch %d failed: %s\n", li, hipGetErrorName(le)); break; } }
    }
}
```
